# Optimizing an MI355X kernel written in HIP

```python
import jax, jax.numpy as jnp
from jax import lax
import numpy as np

D_MODEL = 1024
BATCH = 16
SEQ = 4096
DEPTH = 1

PLE_DIM = 256
MIX_WIDTH = D_MODEL
CONV_WIDTH = MIX_WIDTH // 2
GROUP_DIM = 64
N_CONV_GROUPS = CONV_WIDTH // GROUP_DIM
CONV_K = 3
ATTN_WIDTH = MIX_WIDTH - CONV_WIDTH
HEAD_DIM = GROUP_DIM
N_ATTN_HEADS = ATTN_WIDTH // HEAD_DIM
D_FF = -(-8 * D_MODEL // (3 * 256)) * 256
Q_BLOCK = 128
EPS = 1e-6
IN_COLS = 3 * CONV_WIDTH + 3 * ATTN_WIDTH + N_ATTN_HEADS

kernel_name = "hybrid_conv_forgetting_attn_ple_layer"


def rms_norm(x, g):
    xf = x.astype(jnp.float32)
    y = xf * lax.rsqrt(jnp.mean(xf * xf, axis=-1, keepdims=True) + EPS)
    return (y * g.astype(jnp.float32)).astype(x.dtype)


def group_rms_norm(y, g):
    B, S, W = y.shape
    yf = y.astype(jnp.float32).reshape(B, S, W // GROUP_DIM, GROUP_DIM)
    yf = yf * lax.rsqrt(jnp.mean(yf * yf, axis=-1, keepdims=True) + EPS)
    return (yf.reshape(B, S, W) * g.astype(jnp.float32)).astype(y.dtype)


def causal_depthwise_conv(u, w):
    S = u.shape[1]
    u_pad = jnp.pad(u, ((0, 0), (CONV_K - 1, 0), (0, 0)))
    return sum(w[j] * u_pad[:, j:j + S] for j in range(CONV_K))


def forgetting_attention(q, k, v, log_f):
    B, S, H, dh = q.shape
    nb = S // Q_BLOCK
    c = jnp.cumsum(log_f, axis=1)
    c_k = c.transpose(0, 2, 1)
    qf = q.astype(jnp.float32) * (dh ** -0.5)
    kf = k.astype(jnp.float32)
    vf = v.astype(jnp.float32)
    q_blocks = qf.reshape(B, nb, Q_BLOCK, H, dh).transpose(1, 0, 2, 3, 4)
    c_blocks = c.reshape(B, nb, Q_BLOCK, H).transpose(1, 0, 3, 2)
    k_pos = jnp.arange(S)

    def one_block(args):
        q_blk, c_q, blk = args
        s = jnp.einsum('bqhd,bkhd->bhqk', q_blk, kf)
        s = s + c_q[..., :, None] - c_k[:, :, None, :]
        q_pos = blk * Q_BLOCK + jnp.arange(Q_BLOCK)
        causal = k_pos[None, :] <= q_pos[:, None]
        s = jnp.where(causal, s, -jnp.inf)
        pr = jax.nn.softmax(s, axis=-1)
        return jnp.einsum('bhqk,bkhd->bqhd', pr, vf)

    out = lax.map(one_block, (q_blocks, c_blocks, jnp.arange(nb)))
    return out.transpose(1, 0, 2, 3, 4).reshape(B, S, H, dh).astype(v.dtype)


def setup_inputs(seed: int = 0) -> dict:
    key = jax.random.key(seed)
    ks = jax.random.split(key, 20)
    f32 = jnp.float32
    nrm = lambda k, shape, fan_in: jax.random.normal(k, shape, f32) * (fan_in ** -0.5)
    gain = lambda k, shape: 1.0 + 0.05 * jax.random.normal(k, shape, f32)
    x = jax.random.normal(ks[0], (BATCH, SEQ, D_MODEL), f32)
    p = jax.random.normal(ks[1], (DEPTH, BATCH, SEQ, PLE_DIM), f32)
    mix_norm = gain(ks[2], (DEPTH, D_MODEL))
    w_in = nrm(ks[3], (DEPTH, D_MODEL, IN_COLS), D_MODEL)
    b_f = (jnp.linspace(1.0, 6.0, N_ATTN_HEADS, dtype=f32)[None, :]
           + 0.01 * jax.random.normal(ks[4], (DEPTH, N_ATTN_HEADS), f32))
    conv_w = nrm(ks[5], (DEPTH, CONV_K, CONV_WIDTH), CONV_K)
    mix_out_norm = gain(ks[6], (DEPTH, MIX_WIDTH))
    w_o = nrm(ks[7], (DEPTH, MIX_WIDTH, D_MODEL), MIX_WIDTH)
    ffn_norm = gain(ks[8], (DEPTH, D_MODEL))
    w_gate_up = nrm(ks[9], (DEPTH, D_MODEL, 2 * D_FF), D_MODEL)
    w_down = nrm(ks[10], (DEPTH, D_FF, D_MODEL), D_FF)
    ple_norm = gain(ks[11], (DEPTH, D_MODEL))
    w_ple_gate = nrm(ks[12], (DEPTH, D_MODEL, D_MODEL), D_MODEL)
    b_ple_gate = 0.01 * jax.random.normal(ks[13], (DEPTH, D_MODEL), f32)
    w_ple_proj = nrm(ks[14], (DEPTH, PLE_DIM, D_MODEL), PLE_DIM)
    final_norm = gain(ks[15], (D_MODEL,))
    return {"x": x, "p": p, "mix_norm": mix_norm, "w_in": w_in, "b_f": b_f,
            "conv_w": conv_w, "mix_out_norm": mix_out_norm, "w_o": w_o,
            "ffn_norm": ffn_norm, "w_gate_up": w_gate_up, "w_down": w_down,
            "ple_norm": ple_norm, "w_ple_gate": w_ple_gate, "b_ple_gate": b_ple_gate,
            "w_ple_proj": w_ple_proj, "final_norm": final_norm}


def reference(x, p, mix_norm, w_in, b_f, conv_w, mix_out_norm, w_o, ffn_norm,
              w_gate_up, w_down, ple_norm, w_ple_gate, b_ple_gate, w_ple_proj,
              final_norm):
    B, S, _ = x.shape
    o_b = 0
    o_c = o_b + CONV_WIDTH
    o_u = o_c + CONV_WIDTH
    o_q = o_u + CONV_WIDTH
    o_k = o_q + ATTN_WIDTH
    o_v = o_k + ATTN_WIDTH
    o_f = o_v + ATTN_WIDTH
    h = x
    for i in range(DEPTH):
        xn = rms_norm(h, mix_norm[i])
        z = jnp.einsum('bsd,de->bse', xn, w_in[i])
        gate_b = z[..., o_b:o_c]
        gate_c = z[..., o_c:o_u]
        u = z[..., o_u:o_q]
        y_conv = gate_b * causal_depthwise_conv(gate_c * u, conv_w[i])
        q = z[..., o_q:o_k].reshape(B, S, N_ATTN_HEADS, HEAD_DIM)
        k = z[..., o_k:o_v].reshape(B, S, N_ATTN_HEADS, HEAD_DIM)
        v = z[..., o_v:o_f].reshape(B, S, N_ATTN_HEADS, HEAD_DIM)
        log_f = jax.nn.log_sigmoid(z[..., o_f:].astype(jnp.float32)
                                   + b_f[i].astype(jnp.float32))
        y_attn = forgetting_attention(q, k, v, log_f).reshape(B, S, ATTN_WIDTH)
        y = group_rms_norm(jnp.concatenate([y_conv, y_attn], axis=-1), mix_out_norm[i])
        h = h + jnp.einsum('bse,ed->bsd', y, w_o[i])
        gu = jnp.einsum('bsd,df->bsf', rms_norm(h, ffn_norm[i]), w_gate_up[i])
        g, up = gu[..., :D_FF], gu[..., D_FF:]
        h = h + jnp.einsum('bsf,fd->bsd', jax.nn.silu(g) * up, w_down[i])
        gate = jax.nn.sigmoid(jnp.einsum('bsd,de->bse', rms_norm(h, ple_norm[i]), w_ple_gate[i])
                              + b_ple_gate[i])
        h = h + gate * jnp.einsum('bsp,pd->bsd', p[i], w_ple_proj[i])
    return rms_norm(h, final_norm)
```

```cpp
#include <hip/hip_runtime.h>
#include <hip/hip_bf16.h>
#include <cstdio>
#include <cstdint>
#include <cmath>

constexpr int NB = 16, SEQ = 4096, DM = 1024, MTOK = NB * SEQ, NH = 8, HD = 64, FF = 2816, PLE = 256, NZ = 3072, INC = 3080;
constexpr float EPS = 1e-6f;
constexpr float LOG2E = 1.4426950408889634f;
constexpr float QSCALE = 0.125f * 1.4426950408889634f;
#ifndef CFG_NAIVE_GEMM
#define CFG_NAIVE_GEMM 0
#endif
#ifndef CFG_NAIVE_ATTN
#define CFG_NAIVE_ATTN 0
#endif
#ifndef CFG_ONE_LAUNCH
#define CFG_ONE_LAUNCH 1
#endif

namespace pg8 {
#define PG8_LAS __attribute__((address_space(3)))
typedef unsigned short bf16_t;
typedef short bf16x8 __attribute__((ext_vector_type(8)));
typedef float f32x4 __attribute__((ext_vector_type(4)));
typedef unsigned u32x4 __attribute__((ext_vector_type(4)));
constexpr int BM = 256, BK = 64, HALF = 128, HTB = HALF * BK * 2  , STAGE_BYTES = 8 * HTB, NXCD = 8, WGM = 8;

__host__ __device__ __forceinline__ int lds_byte(int r, int c) { const int st = (r >> 4) * 2 + (c >> 5), rr = r & 15, cc = c & 31, ob = rr * 64 + cc * 2; return st * 1024 + (ob ^ (((ob >> 9) & 1) << 5)); }
__host__ __device__ __forceinline__ void stage_rc(int b, int& R, int& C) { const int st = b / 1024, sb = b % 1024, swz = sb ^ (((sb >> 9) & 1) << 5); R = (st >> 1) * 16 + swz / 64; C = (st & 1) * 32 + (swz % 64) / 2; }
__host__ __device__ __forceinline__ int perm32(int rho) { const int n = rho >> 4, i = rho & 15; return 8 * (i >> 2) + 4 * n + (i & 3); }

struct Unit { int pm, pn; };
struct Gemm { const bf16_t* A; const bf16_t* Bt; int M, N, K; };

struct StaticOrder {
    int nM, nN, nwg, G, c;
    __host__ __device__ void init(int M, int N, int G_, int c_) { nM = M / BM; nN = N / BM; nwg = nM * nN; G = G_; c = c_; }
    __host__ __device__ bool next(int i, Unit& u) const {
        const long L = (long)i * G + c; if (L >= nwg) return false;
        int wgid = (int)L; { const int q = nwg / NXCD, r = nwg % NXCD, xcd = wgid % NXCD, off = wgid / NXCD; wgid = (xcd < r ? xcd * (q + 1) : r * (q + 1) + (xcd - r) * q) + off; }
        const int nig = WGM * nN, gid = wgid / nig, fm = gid * WGM, gsz = (nM - fm) < WGM ? (nM - fm) : WGM;
        u.pm = fm + ((wgid % nig) % gsz); u.pn = (wgid % nig) / gsz; return true;
    }
    __device__ __forceinline__ void a_ready(const Unit&) const {}
    __device__ __forceinline__ void done(const Unit&) const {}
};

__device__ __forceinline__ unsigned cvt_pk_bf16(float lo, float hi) { unsigned r; asm volatile("v_cvt_pk_bf16_f32 %0, %1, %2" : "=v"(r) : "v"(lo), "v"(hi)); return r; }
typedef float f32x2 __attribute__((ext_vector_type(2)));
typedef unsigned u32x2 __attribute__((ext_vector_type(2)));
__device__ __forceinline__ float bf_lo(unsigned w) { return __uint_as_float(w << 16); }
__device__ __forceinline__ float bf_hi(unsigned w) { return __uint_as_float(w & 0xffff0000u); }
__device__ __forceinline__ float sq8(const u32x4 w) {
    float s = 0.f;
    s += bf_lo(w.x) * bf_lo(w.x); s += bf_hi(w.x) * bf_hi(w.x); s += bf_lo(w.y) * bf_lo(w.y); s += bf_hi(w.y) * bf_hi(w.y);
    s += bf_lo(w.z) * bf_lo(w.z); s += bf_hi(w.z) * bf_hi(w.z); s += bf_lo(w.w) * bf_lo(w.w); s += bf_hi(w.w) * bf_hi(w.w);
    return s;
}
__device__ __forceinline__ u32x4 pack8(const f32x4 v0, const f32x4 v1) { u32x4 w; w.x = cvt_pk_bf16(v0[0], v0[1]); w.y = cvt_pk_bf16(v0[2], v0[3]); w.z = cvt_pk_bf16(v1[0], v1[1]); w.w = cvt_pk_bf16(v1[2], v1[3]); return w; }
__device__ __forceinline__ float row_rstd(const float* ssq, int row) {
    const f32x4* p = (const f32x4*)(ssq + (size_t)row * 16);
    const f32x4 a = p[0], b = p[1], c = p[2], d = p[3];
    const float s = ((a[0] + a[1]) + (a[2] + a[3])) + ((b[0] + b[1]) + (b[2] + b[3])) + ((c[0] + c[1]) + (c[2] + c[3])) + ((d[0] + d[1]) + (d[2] + d[3]));
    return __builtin_amdgcn_rsqf(s * (1.0f / 1024.0f) + 1e-6f);
}
__device__ __forceinline__ float sigmoid_f(float v) { return __builtin_amdgcn_rcpf(1.0f + __builtin_amdgcn_exp2f(-1.4426950408889634f * v)); }

struct EpiBf16Plain {
    static constexpr bool PERM = true, AFTER_DRAIN = false;
    bf16_t* O; int ldc; int sc_lo, sc_hi; float scale;
    __device__ __forceinline__ void operator()(const f32x4 (&acc)[2][2][4][2], const Unit& u, int wr, int wc, int fr, int fq) const {
        const int row0 = u.pm * BM + wr * 64 + fr, col0 = u.pn * BM + wc * 32 + 8 * fq;
        const float sc = (u.pn >= sc_lo && u.pn < sc_hi) ? scale : 1.f;
#pragma unroll
        for (int ai = 0; ai < 2; ++ai)
#pragma unroll
            for (int m = 0; m < 4; ++m) { bf16_t* rowp = O + (size_t)(row0 + ai * HALF + m * 16) * ldc + col0;
#pragma unroll
                for (int bj = 0; bj < 2; ++bj) { const u32x4 w = pack8(acc[ai][bj][m][0] * sc, acc[ai][bj][m][1] * sc); *(u32x4*)(rowp + bj * HALF) = w; } }
    }
};
template <bool XF32> struct EpiRes {
    static constexpr bool PERM = true, AFTER_DRAIN = false;
    const float* X; const bf16_t* Hin; bf16_t* H; float* SSQ;
    __device__ __forceinline__ void operator()(const f32x4 (&acc)[2][2][4][2], const Unit& u, int wr, int wc, int fr, int fq) const {
        const int row0 = u.pm * BM + wr * 64 + fr, col0 = u.pn * BM + wc * 32 + 8 * fq;
#pragma unroll
        for (int ai = 0; ai < 2; ++ai)
#pragma unroll
            for (int m = 0; m < 4; ++m) { const int row = row0 + ai * HALF + m * 16; const size_t off = (size_t)row * 1024 + col0; float s = 0.f;
#pragma unroll
                for (int bj = 0; bj < 2; ++bj) { f32x4 b0, b1;
                    if (XF32) { b0 = *(const f32x4*)(X + off + bj * HALF); b1 = *(const f32x4*)(X + off + bj * HALF + 4); }
                    else { const u32x4 hw = *(const u32x4*)(Hin + off + bj * HALF); b0 = (f32x4){bf_lo(hw.x), bf_hi(hw.x), bf_lo(hw.y), bf_hi(hw.y)}; b1 = (f32x4){bf_lo(hw.z), bf_hi(hw.z), bf_lo(hw.w), bf_hi(hw.w)}; }
                    const u32x4 w = pack8(acc[ai][bj][m][0] + b0, acc[ai][bj][m][1] + b1); *(u32x4*)(H + off + bj * HALF) = w; s += sq8(w); }
                s += __shfl_xor(s, 16); s += __shfl_xor(s, 32);
                if (fq == 0) SSQ[(size_t)row * 16 + u.pn * 4 + wc] = s;
                asm volatile("" ::: "memory"); }
    }
};
struct EpiSwiglu {
    static constexpr bool PERM = true, AFTER_DRAIN = false;
    bf16_t* ACT; const float* SSQ;
    __device__ __forceinline__ void operator()(const f32x4 (&acc)[2][2][4][2], const Unit& u, int wr, int wc, int fr, int fq) const {
        const int row0 = u.pm * BM + wr * 64 + fr, col0 = u.pn * HALF + wc * 32 + 8 * fq;
#pragma unroll
        for (int ai = 0; ai < 2; ++ai)
#pragma unroll
            for (int m = 0; m < 4; ++m) { const int row = row0 + ai * HALF + m * 16; const float rs = row_rstd(SSQ, row);
                f32x4 o[2];
#pragma unroll
                for (int n = 0; n < 2; ++n) { const f32x4 g = acc[ai][0][m][n] * rs, up = acc[ai][1][m][n] * rs;
#pragma unroll
                    for (int i = 0; i < 4; ++i) o[n][i] = g[i] * sigmoid_f(g[i]) * up[i]; }
                *(u32x4*)(ACT + (size_t)row * 2816 + col0) = pack8(o[0], o[1]);
                asm volatile("" ::: "memory"); }
    }
};
struct EpiPle {
    static constexpr bool PERM = true, AFTER_DRAIN = false;
    const bf16_t* H2; const bf16_t* PROJ; const float* SSQ; const float* bg; float* OUT;
    __device__ __forceinline__ void operator()(const f32x4 (&acc)[2][2][4][2], const Unit& u, int wr, int wc, int fr, int fq) const {
        const int row0 = u.pm * BM + wr * 64 + fr, col0 = u.pn * BM + wc * 32 + 8 * fq;
        f32x4 bv[2][2];
#pragma unroll
        for (int bj = 0; bj < 2; ++bj)
#pragma unroll
            for (int n = 0; n < 2; ++n) bv[bj][n] = *(const f32x4*)(bg + col0 + bj * HALF + 4 * n);
#pragma unroll
        for (int ai = 0; ai < 2; ++ai)
#pragma unroll
            for (int m = 0; m < 4; ++m) { const int row = row0 + ai * HALF + m * 16; const size_t off = (size_t)row * 1024 + col0; const float rs = row_rstd(SSQ, row);
#pragma unroll
                for (int bj = 0; bj < 2; ++bj) { const u32x4 hw = *(const u32x4*)(H2 + off + bj * HALF), pw = *(const u32x4*)(PROJ + off + bj * HALF);
                    const f32x4 h0 = (f32x4){bf_lo(hw.x), bf_hi(hw.x), bf_lo(hw.y), bf_hi(hw.y)}, h1 = (f32x4){bf_lo(hw.z), bf_hi(hw.z), bf_lo(hw.w), bf_hi(hw.w)};
                    const f32x4 p0 = (f32x4){bf_lo(pw.x), bf_hi(pw.x), bf_lo(pw.y), bf_hi(pw.y)}, p1 = (f32x4){bf_lo(pw.z), bf_hi(pw.z), bf_lo(pw.w), bf_hi(pw.w)};
                    const f32x4 a0 = acc[ai][bj][m][0] * rs + bv[bj][0], a1 = acc[ai][bj][m][1] * rs + bv[bj][1]; f32x4 o0, o1;
#pragma unroll
                    for (int i = 0; i < 4; ++i) { o0[i] = h0[i] + sigmoid_f(a0[i]) * p0[i]; o1[i] = h1[i] + sigmoid_f(a1[i]) * p1[i]; }
                    *(f32x4*)(OUT + off + bj * HALF) = o0; *(f32x4*)(OUT + off + bj * HALF + 4) = o1; }
                asm volatile("" ::: "memory"); }
    }
};

template <class Epi, class Sched, bool ALIGN_EPI = false, bool SP2 = false>
__device__ __forceinline__ void gemm_phase(PG8_LAS unsigned char* lds, const Gemm g, const Sched& S, const Epi& E) {
    const int tid = threadIdx.x, wid = __builtin_amdgcn_readfirstlane(tid >> 6), lane = tid & 63, wr = wid >> 2, wc = wid & 3, fr = lane & 15, fq = lane >> 4;
    const int K = g.K, nt = K / BK;
    unsigned voffA[2], voffB[2];
#pragma unroll
    for (int i = 0; i < 2; ++i) { int R, C; stage_rc(tid * 16 + i * 8192, R, C); const int Rb = Epi::PERM ? ((R & ~31) + perm32(R & 31)) : R;
        voffA[i] = (unsigned)(R * K + C) * 2u; voffB[i] = (unsigned)(Rb * K + C) * 2u; }
    const size_t kstep = (size_t)(BK * 2);
    const size_t hstep = (size_t)HALF * K * 2;
    const size_t tstep = 2 * hstep;
    const unsigned ldsw = (unsigned)wid * 1024u;
    const int aoff = lds_byte(wr * 64 + fr, fq * 8), boff = lds_byte(wc * 32 + fr, fq * 8);
#define PG8_SA(b, h) (((b) * 2 + (h)) * HTB)
#define PG8_SB(b, h) ((4 + (b) * 2 + (h)) * HTB)
#define PG8_STAGE(bufoff, gbase, voff) do { _Pragma("unroll") for (int _i = 0; _i < 2; ++_i) \
        __builtin_amdgcn_global_load_lds((const unsigned*)((const char*)(gbase) + (voff)[_i]), (PG8_LAS unsigned*)(lds + (bufoff) + ldsw + _i * 8192), 16, 0, 0); } while (0)
#define PG8_LDA(dst, b, h) do { _Pragma("unroll") for (int m = 0; m < 4; ++m) _Pragma("unroll") for (int k = 0; k < 2; ++k) dst[m][k] = *(const PG8_LAS bf16x8*)(lds + PG8_SA(b, h) + aoff + m * 2048 + k * 1024); } while (0)
#define PG8_LDB(dst, b, h) do { _Pragma("unroll") for (int n = 0; n < 2; ++n) _Pragma("unroll") for (int k = 0; k < 2; ++k) dst[n][k] = *(const PG8_LAS bf16x8*)(lds + PG8_SB(b, h) + boff + n * 2048 + k * 1024); } while (0)
#define PG8_MMA(ai, bj, At, Bt) do { __builtin_amdgcn_s_setprio(1); _Pragma("unroll") for (int m = 0; m < 4; ++m) _Pragma("unroll") for (int n = 0; n < 2; ++n) _Pragma("unroll") for (int k = 0; k < 2; ++k) \
        acc[ai][bj][m][n] = __builtin_amdgcn_mfma_f32_16x16x32_bf16(Bt[n][k], At[m][k], acc[ai][bj][m][n], 0, 0, 0); __builtin_amdgcn_s_setprio(0); } while (0)
#define PG8_WAIT_V(n) asm volatile("s_waitcnt vmcnt(" #n ")" ::: "memory")
#define PG8_WAIT_L(n) asm volatile("s_waitcnt lgkmcnt(" #n ")" ::: "memory")
#define PG8_BAR __builtin_amdgcn_s_barrier()
#define PG8_SCHED __builtin_amdgcn_sched_barrier(0)
    Unit cur, nxt; int ui = 0;
    if (!S.next(0, cur)) return;
    f32x4 acc[2][2][4][2];
#pragma unroll
    for (int a = 0; a < 2; ++a)
#pragma unroll
        for (int b = 0; b < 2; ++b)
#pragma unroll
            for (int m = 0; m < 4; ++m)
#pragma unroll
                for (int n = 0; n < 2; ++n) acc[a][b][m][n] = (f32x4){0.f, 0.f, 0.f, 0.f};
    bf16x8 At[4][2], B0[2][2], B1[2][2];
    const char* cA = (const char*)g.A + (size_t)cur.pm * tstep; const char* cB = (const char*)g.Bt + (size_t)cur.pn * tstep;
    S.a_ready(cur);
    if constexpr (SP2) {
        PG8_STAGE(PG8_SB(0, 0), cB, voffB); PG8_STAGE(PG8_SB(0, 1), cB + hstep, voffB); PG8_STAGE(PG8_SA(0, 0), cA, voffA); PG8_STAGE(PG8_SA(0, 1), cA + hstep, voffA);
        if (wr == 1) PG8_BAR;
        PG8_WAIT_V(2); PG8_BAR;
        PG8_STAGE(PG8_SB(1, 0), cB + kstep, voffB); PG8_STAGE(PG8_SA(1, 0), cA + kstep, voffA); PG8_STAGE(PG8_SB(1, 1), cB + hstep + kstep, voffB);
        PG8_WAIT_V(6); PG8_BAR;
    } else {
        PG8_STAGE(PG8_SB(0, 0), cB, voffB); PG8_STAGE(PG8_SA(0, 0), cA, voffA); PG8_STAGE(PG8_SB(0, 1), cB + hstep, voffB); PG8_STAGE(PG8_SA(0, 1), cA + hstep, voffA);
        if (wr == 1) PG8_BAR;
        PG8_WAIT_V(4); PG8_BAR;
        PG8_STAGE(PG8_SB(1, 0), cB + kstep, voffB); PG8_STAGE(PG8_SA(1, 0), cA + kstep, voffA); PG8_STAGE(PG8_SB(1, 1), cB + hstep + kstep, voffB);
        PG8_WAIT_V(6); PG8_BAR;
    }
    for (;;) {
        const bool has_next = S.next(ui + 1, nxt);
        const char* nA = has_next ? (const char*)g.A + (size_t)nxt.pm * tstep : cA; const char* nB = has_next ? (const char*)g.Bt + (size_t)nxt.pn * tstep : cB;
        for (int t = 0; t < nt; t += 2) {
            const bool last = (t == nt - 2);
            const char* a1 = cA + (size_t)(t + 1) * kstep;
            const char* a2 = last ? nA : cA + (size_t)(t + 2) * kstep; const char* b2 = last ? nB : cB + (size_t)(t + 2) * kstep;
            const char* a3 = a2 + kstep; const char* b3 = b2 + kstep;
            if (last && has_next) S.a_ready(nxt);
            if constexpr (SP2) {
            PG8_LDB(B0, 0, 0); PG8_LDB(B1, 0, 1); PG8_SCHED; PG8_LDA(At, 0, 0); PG8_STAGE(PG8_SA(1, 1), a1 + hstep, voffA);
            PG8_WAIT_V(8); PG8_WAIT_L(0); PG8_BAR; PG8_MMA(0, 0, At, B0); PG8_MMA(0, 1, At, B1); PG8_BAR; PG8_SCHED;
            PG8_LDA(At, 0, 1); PG8_STAGE(PG8_SB(0, 0), b2, voffB); PG8_STAGE(PG8_SB(0, 1), b2 + hstep, voffB); PG8_STAGE(PG8_SA(0, 0), a2, voffA);
            PG8_WAIT_V(8); PG8_WAIT_L(0); PG8_BAR; PG8_MMA(1, 0, At, B0); PG8_MMA(1, 1, At, B1); PG8_BAR; PG8_SCHED;
            PG8_LDB(B0, 1, 0); PG8_LDB(B1, 1, 1); PG8_SCHED; PG8_LDA(At, 1, 0); PG8_STAGE(PG8_SA(0, 1), a2 + hstep, voffA);
            PG8_WAIT_V(8); PG8_WAIT_L(0); PG8_BAR; PG8_MMA(0, 0, At, B0); PG8_MMA(0, 1, At, B1); PG8_BAR; PG8_SCHED;
            PG8_LDA(At, 1, 1); PG8_STAGE(PG8_SB(1, 0), b3, voffB); PG8_STAGE(PG8_SB(1, 1), b3 + hstep, voffB); PG8_STAGE(PG8_SA(1, 0), a3, voffA);
            PG8_WAIT_V(8); PG8_WAIT_L(0); PG8_BAR; PG8_MMA(1, 0, At, B0); PG8_MMA(1, 1, At, B1); PG8_BAR; PG8_SCHED;
            } else {
            PG8_LDB(B0, 0, 0); PG8_SCHED; PG8_LDA(At, 0, 0); PG8_STAGE(PG8_SA(1, 1), a1 + hstep, voffA);
            PG8_WAIT_L(8); PG8_BAR; PG8_WAIT_L(0); PG8_MMA(0, 0, At, B0); PG8_BAR; PG8_SCHED;
            PG8_LDB(B1, 0, 1); PG8_STAGE(PG8_SB(0, 0), b2, voffB);
            PG8_BAR; PG8_WAIT_L(0); PG8_MMA(0, 1, At, B1); PG8_BAR;
            PG8_LDA(At, 0, 1); PG8_STAGE(PG8_SA(0, 0), a2, voffA);
            PG8_BAR; PG8_WAIT_L(0); PG8_MMA(1, 0, At, B0); PG8_BAR; PG8_SCHED;
            PG8_STAGE(PG8_SB(0, 1), b2 + hstep, voffB);
            PG8_WAIT_V(6); PG8_BAR; PG8_MMA(1, 1, At, B1); PG8_BAR;
            PG8_LDB(B0, 1, 0); PG8_SCHED; PG8_LDA(At, 1, 0); PG8_STAGE(PG8_SA(0, 1), a2 + hstep, voffA);
            PG8_WAIT_L(8); PG8_BAR; PG8_WAIT_L(0); PG8_MMA(0, 0, At, B0); PG8_BAR; PG8_SCHED;
            PG8_LDB(B1, 1, 1); PG8_STAGE(PG8_SB(1, 0), b3, voffB);
            PG8_BAR; PG8_WAIT_L(0); PG8_MMA(0, 1, At, B1); PG8_BAR;
            PG8_LDA(At, 1, 1); PG8_STAGE(PG8_SA(1, 0), a3, voffA);
            PG8_BAR; PG8_WAIT_L(0); PG8_MMA(1, 0, At, B0); PG8_BAR; PG8_SCHED;
            PG8_STAGE(PG8_SB(1, 1), b3 + hstep, voffB);
            PG8_WAIT_V(6); PG8_BAR; PG8_MMA(1, 1, At, B1); PG8_BAR;
            }
        }
        if constexpr (ALIGN_EPI) { if (wr == 0) PG8_BAR; }
        if constexpr (!Epi::AFTER_DRAIN) { E(acc, cur, wr, wc, fr, fq); S.done(cur); }
        if (!has_next) break;
#pragma unroll
        for (int a = 0; a < 2; ++a)
#pragma unroll
            for (int b = 0; b < 2; ++b)
#pragma unroll
                for (int m = 0; m < 4; ++m)
#pragma unroll
                    for (int n = 0; n < 2; ++n) acc[a][b][m][n] = (f32x4){0.f, 0.f, 0.f, 0.f};
        cur = nxt; cA = nA; cB = nB; ++ui;
        if constexpr (ALIGN_EPI) { if (wr == 1) PG8_BAR; }
    }
    PG8_WAIT_V(0);
    if constexpr (!ALIGN_EPI) { if (wr == 0) PG8_BAR; }
    PG8_BAR;
    if constexpr (Epi::AFTER_DRAIN) { E.fused(acc, cur, wr, wc, fr, fq, lds, wid, lane); S.done(cur); }
#undef PG8_SA
#undef PG8_SB
#undef PG8_STAGE
#undef PG8_LDA
#undef PG8_LDB
#undef PG8_MMA
#undef PG8_WAIT_V
#undef PG8_WAIT_L
#undef PG8_BAR
#undef PG8_SCHED
}
}

#ifndef PG8_SP2
#define PG8_SP2 true
#endif
#ifndef PG8_ALIGN
#define PG8_ALIGN true
#endif
namespace attn_body {
using bf16=__hip_bfloat16;
using bf16x8=__attribute__((ext_vector_type(8)))short;
using s16x4=__attribute__((ext_vector_type(4)))short;
using f32x16=__attribute__((ext_vector_type(16)))float;
using f32x4a=__attribute__((ext_vector_type(4)))float;
using u32x4=__attribute__((ext_vector_type(4)))unsigned;
constexpr int NHEAD=8,SEQL=4096,D=64,DMI=3072,DMO=1024;
constexpr int NW=8,QBLK=32,QB=QBLK*NW,KVBLK=64,NQB=SEQL/QB;
__device__ __forceinline__ int crow(int r,int hi){return (r&3)+8*(r>>2)+4*hi;}
#define SBAR() __builtin_amdgcn_sched_barrier(0)
__device__ __forceinline__ void cmask(f32x16&p0,f32x16&p1,int jb,int qrel,int hi){
  const float NEG=-INFINITY; int kb=64*jb+4*hi; asm volatile("":"+v"(kb));
  #pragma unroll
  for(int r=0;r<16;++r){int kv=kb+(r&3)+8*(r>>2); if(kv>qrel)p0[r]=NEG; if(kv+32>qrel)p1[r]=NEG;}
}

constexpr int NSLOT=3, SLOTB=8192;
constexpr int LDS_K=0, LDS_V=NSLOT*SLOTB, LDS_WS=2*NSLOT*SLOTB, LDS_OST=LDS_WS+NW*64*4, LDS_CLT=LDS_OST+NW*4096, LDS_BYTES=LDS_CLT+SEQL*4;
__device__ __forceinline__ void glds16(const void*gsrc,unsigned lds_dst){unsigned keep;
  asm volatile("s_mov_b32 %0, m0\n\ts_mov_b32 m0, %2\n\ts_nop 0\n\tglobal_load_lds_dwordx4 %1, off\n\ts_mov_b32 m0, %0":"=&s"(keep):"v"(gsrc),"s"(lds_dst):"memory");}
__device__ __forceinline__ float max3f(float a,float b,float c){float r;asm("v_max3_f32 %0, %1, %2, %3":"=v"(r):"v"(a),"v"(b),"v"(c));return r;}
__device__ __forceinline__ float max2f(float a,float b){float r;asm("v_max_f32_e32 %0, %1, %2":"=v"(r):"v"(a),"v"(b));return r;}
typedef float f32x2_t __attribute__((ext_vector_type(2))); typedef __bf16 bf16x2_t __attribute__((ext_vector_type(2)));
__device__ __forceinline__ unsigned cvtpk_s(float lo,float hi){f32x2_t v={lo,hi};bf16x2_t b=__builtin_convertvector(v,bf16x2_t);return __builtin_bit_cast(unsigned,b);}
#define WAIT_BAR(N) asm volatile("s_waitcnt vmcnt(" #N ") lgkmcnt(0)\n\ts_barrier":::"memory")

__device__ __forceinline__ void qkt(f32x16&p0,f32x16&p1,const char*Kslot,const bf16x8*qr,int r32,int hi){
  const char*kb=Kslot+hi*1024+r32*16;
  #pragma unroll
  for(int d0=0;d0<4;++d0){
    const bf16x8 b0=*reinterpret_cast<const bf16x8*>(kb+d0*2048);
    const bf16x8 b1=*reinterpret_cast<const bf16x8*>(kb+d0*2048+512);
    p0=__builtin_amdgcn_mfma_f32_32x32x16_bf16(b0,qr[d0],p0,0,0,0);p1=__builtin_amdgcn_mfma_f32_32x32x16_bf16(b1,qr[d0],p1,0,0,0);}
}
typedef __attribute__((address_space(3))) const char* lds_cptr;
typedef short v4i16_t __attribute__((ext_vector_type(4)));
__device__ __forceinline__ void kload8(bf16x8*kf,lds_cptr kp){
  kf[0]=*(const __attribute__((address_space(3))) bf16x8*)(kp);      kf[1]=*(const __attribute__((address_space(3))) bf16x8*)(kp+512);
  kf[2]=*(const __attribute__((address_space(3))) bf16x8*)(kp+2048); kf[3]=*(const __attribute__((address_space(3))) bf16x8*)(kp+2560);
  kf[4]=*(const __attribute__((address_space(3))) bf16x8*)(kp+4096); kf[5]=*(const __attribute__((address_space(3))) bf16x8*)(kp+4608);
  kf[6]=*(const __attribute__((address_space(3))) bf16x8*)(kp+6144); kf[7]=*(const __attribute__((address_space(3))) bf16x8*)(kp+6656);
}
__device__ __forceinline__ void kload2(bf16x8*kf,lds_cptr kp,int j){ kf[2*j]=*(const __attribute__((address_space(3))) bf16x8*)(kp+j*2048); kf[2*j+1]=*(const __attribute__((address_space(3))) bf16x8*)(kp+j*2048+512); }
__device__ __forceinline__ s16x4 vtr(lds_cptr p){ return __builtin_bit_cast(s16x4,__builtin_amdgcn_ds_read_tr16_b64_v4i16((__attribute__((address_space(3))) v4i16_t*)p)); }
__device__ __forceinline__ float rowmax(const f32x16&p0,const f32x16&p1){
  float a=max3f(p0[0],p0[1],p1[0]),b=max3f(p0[2],p0[3],p1[1]);a=max3f(a,p1[2],p1[3]);
  #pragma unroll
  for(int r=4;r<16;r+=4){a=max3f(a,p0[r],p0[r+1]);b=max3f(b,p0[r+2],p0[r+3]);a=max3f(a,p1[r],p1[r+1]);b=max3f(b,p1[r+2],p1[r+3]);}
  const float m=max2f(a,b);
  auto rr=__builtin_amdgcn_permlane32_swap(__float_as_uint(m),__float_as_uint(m),false,false);
  return max2f(__uint_as_float(rr[0]),__uint_as_float(rr[1]));
}
__device__ __forceinline__ void pv(f32x16*o,int vb,bf16x8 pa0,bf16x8 pa1,bf16x8 pa2,bf16x8 pa3){
  #pragma unroll
  for(int d0=0;d0<2;++d0){s16x4 lo[4],hi[4];
    #pragma unroll
    for(int ks=0;ks<4;++ks){
      asm volatile("ds_read_b64_tr_b16 %0,%1 offset:%c2":"=&v"(lo[ks]):"v"(vb),"i"(d0*4096+ks*1024):"memory");
      asm volatile("ds_read_b64_tr_b16 %0,%1 offset:%c2":"=&v"(hi[ks]):"v"(vb),"i"(d0*4096+ks*1024+512):"memory");}
    asm volatile("s_waitcnt lgkmcnt(0)":::"memory");SBAR();
    #define PK(k) (bf16x8){lo[k][0],lo[k][1],lo[k][2],lo[k][3],hi[k][0],hi[k][1],hi[k][2],hi[k][3]}
    o[d0]=__builtin_amdgcn_mfma_f32_32x32x16_bf16(pa0,PK(0),o[d0],0,0,0);
    o[d0]=__builtin_amdgcn_mfma_f32_32x32x16_bf16(pa1,PK(1),o[d0],0,0,0);
    o[d0]=__builtin_amdgcn_mfma_f32_32x32x16_bf16(pa2,PK(2),o[d0],0,0,0);
    o[d0]=__builtin_amdgcn_mfma_f32_32x32x16_bf16(pa3,PK(3),o[d0],0,0,0);
    #undef PK
  }
}

#ifndef ATTN_STORE16
#define ATTN_STORE16(p,v) (*(u32x4*)(p)=(v))
#endif
template<int THRL> __device__ __forceinline__ void attn_unit(int b,int h,int qb,const bf16*Q,const bf16*__restrict__ K,const bf16*__restrict__ V,bf16*O,const float*CLrow,const float*gout,char*shm){
  int tid_=threadIdx.x; asm volatile("":"+v"(tid_));
  const int tid=tid_,lane=tid&63,r32=lane&31,hi=lane>>5; const int wid=__builtin_amdgcn_readfirstlane(tid>>6);
  const long rowbase=(long)b*SEQL; const int q0=qb*QB;
  const bf16*Qw=Q+(rowbase+q0+wid*QBLK)*DMI+h*D;
  const bf16*Kh=K+rowbase*DMI+h*D,*Vh=V+rowbase*DMI+h*D;
  const unsigned lds0=(unsigned)(uintptr_t)shm;
  float*wsf=(float*)(shm+LDS_WS)+wid*64;
  const lds_cptr shm3=(lds_cptr)shm;
  { __attribute__((address_space(3))) f32x4a* clt4=(__attribute__((address_space(3))) f32x4a*)(shm3+LDS_CLT); const f32x4a*src=(const f32x4a*)CLrow; const int n4=(q0+QB)>>2;
    for(int i=tid;i<n4;i+=NW*64)clt4[i]=src[i]; }
  const bf16*ksrc=Kh+(long)lane*DMI+wid*8;
  const bf16*vsrc=Vh+(long)(16*(wid&3)+(lane>>2))*DMI+(wid>>2)*32+(lane&3)*8;
  const unsigned kdst=lds0+LDS_K+wid*1024, vdst=lds0+LDS_V+wid*1024;
  #define DMA_K(t,slot) glds16(ksrc+(long)(t)*KVBLK*DMI,(unsigned)__builtin_amdgcn_readfirstlane(kdst+(slot)))
  #define DMA_V(t,slot) glds16(vsrc+(long)(t)*KVBLK*DMI,(unsigned)__builtin_amdgcn_readfirstlane(vdst+(slot)))
  const int vb0=(int)(lds0+LDS_V)+((lane>>4)&1)*32+(lane&3)*8+(4*hi+((lane&15)>>2))*64;
  const char*Kbase=shm+LDS_K; bf16x8 kf[8];
  const lds_cptr kp0=shm3+LDS_K+hi*1024+r32*16; const lds_cptr vp0=shm3+LDS_V+((lane>>4)&1)*32+(lane&3)*8+(4*hi+((lane&15)>>2))*64;
  const lds_cptr clp0=shm3+LDS_CLT+hi*16;
  const int NT=(q0+QB)/KVBLK;
  DMA_K(0,0);DMA_V(0,0);DMA_K(1,SLOTB);
  bf16x8 qr[4];
  #pragma unroll
  for(int d0=0;d0<4;++d0)qr[d0]=*reinterpret_cast<const bf16x8*>(&Qw[(long)r32*DMI+d0*16+hi*8]);
  float mhat=0.f,l_reg=0.f;f32x16 o[2];o[0]=f32x16{};o[1]=f32x16{};
  const int qrel=wid*QBLK+r32;
  #define CMASK(P0,P1,t) do{int jb_=(t)-(NT-4); if(jb_>=0)cmask(P0,P1,jb_,qrel,hi);}while(0)
  #define CQ(C,g_,off_) do{ const f32x4a a_=*(const __attribute__((address_space(3))) f32x4a*)(cp_+32*(g_)+(off_)); \
      C[4*(g_)]=base_-a_[0]; C[4*(g_)+1]=base_-a_[1]; C[4*(g_)+2]=base_-a_[2]; C[4*(g_)+3]=base_-a_[3]; }while(0)
  #define CINIT(C0,C1,t) do{ const lds_cptr cp_=clp0+(t)*256; const float base_=cql-mhat; \
    CQ(C0,0,0); CQ(C0,1,0); SBAR(); CQ(C0,2,0); CQ(C0,3,0); SBAR(); CQ(C1,0,128); CQ(C1,1,128); SBAR(); CQ(C1,2,128); CQ(C1,3,128); }while(0)
  bool resc=false;
  #define RESC() do{ if(resc){ asm volatile("s_waitcnt lgkmcnt(0)":::"memory"); \
      _Pragma("unroll") for(int d_=0;d_<2;++d_) _Pragma("unroll") for(int r=0;r<16;++r)o[d_][r]*=wsf[crow(r,hi)]; } }while(0)
  f32x16 pA0,pA1,pB0,pB1;
  int sl_prev=0,sl_cur=0,sl_next=SLOTB;
  #define ROT() do{sl_prev=sl_cur;sl_cur=sl_next;sl_next=(sl_next==(NSLOT-1)*SLOTB)?0:sl_next+SLOTB;}while(0)
  DMA_K(2,2*SLOTB);
  WAIT_BAR(3);
  const float cql=*(const __attribute__((address_space(3))) float*)(shm3+LDS_CLT+(q0+qrel)*4);
  CINIT(pA0,pA1,0);
  qkt(pA0,pA1,Kbase,qr,r32,hi);CMASK(pA0,pA1,0);
  { const float rm=rowmax(pA0,pA1);
    if(__any(rm>(float)THRL)){ const float dl=__builtin_fmaxf(rm,0.f); mhat+=dl;
      _Pragma("unroll") for(int r=0;r<16;++r){pA0[r]-=dl;pA1[r]-=dl;} }
    _Pragma("unroll") for(int r=0;r<16;++r){pA0[r]=__builtin_amdgcn_exp2f(pA0[r]);pA1[r]=__builtin_amdgcn_exp2f(pA1[r]);} }
  WAIT_BAR(0);
  DMA_K(3,0);DMA_V(1,SLOTB);
  ROT();
  kload8(kf,kp0+sl_cur);
  WAIT_BAR(2);
  s16x4 vlo[8],vhi[8]; u32x4 pw0,pw1,pw2,pw3;
  #define PKW(P,B) cvtpk_s(P[B],P[B+1])
  #define PAF(k) __builtin_bit_cast(bf16x8,pw##k)
  #define VFR(i) (bf16x8){vlo[i][0],vlo[i][1],vlo[i][2],vlo[i][3],vhi[i][0],vhi[i][1],vhi[i][2],vhi[i][3]}
  #define PIN(x) asm volatile("":"+v"(x))
  #define MX3(a,b,c) __builtin_fmaxf(__builtin_fmaxf((a),(b)),(c))
  #define GAPA(MF,A0,A1,A2,A3,W0,W1,PW) do{ MF; sacc+=A0; sacc+=A1; sacc+=A2; sacc+=A3; PIN(sacc); W0; W1; PIN(PW); SBAR(); }while(0)
  #define EX(v) __builtin_amdgcn_exp2f(v)
  #define GAPB(MF,X,B) do{ MF; X[B]=EX(X[B]); X[B+1]=EX(X[B+1]); X[B+2]=EX(X[B+2]); X[B+3]=EX(X[B+3]); PIN(X); SBAR(); }while(0)
  #define VRD(i) do{ vlo[i]=vtr(vp_+(((i)>>2)*4096+((i)&3)*1024)); vhi[i]=vtr(vp_+(((i)>>2)*4096+((i)&3)*1024+512)); }while(0)
  #define KRD(G,j) do{ if(G){ kload2(kf,kp0+sl_next,j); SBAR(); } }while(0)
  #define STEP(C0,C1,P0,P1,t,GK,GV,GL) do{ SBAR(); \
    CINIT(C0,C1,t); SBAR(); \
    const lds_cptr vp_=vp0+sl_prev; \
    VRD(0); SBAR(); float sacc=(P0[0]+P0[1]); \
    GAPA(C0=__builtin_amdgcn_mfma_f32_32x32x16_bf16(kf[0],qr[0],C0,0,0,0), P0[2],P0[3],P0[4],P0[5],     pw0[0]=PKW(P0,0), pw0[1]=PKW(P0,2), pw0); \
    VRD(4); SBAR(); GAPA(C1=__builtin_amdgcn_mfma_f32_32x32x16_bf16(kf[1],qr[0],C1,0,0,0), P0[6],P0[7],P0[8],P0[9],     pw0[2]=PKW(P0,4), pw0[3]=PKW(P0,6), pw0); \
    VRD(1); SBAR(); GAPA(C0=__builtin_amdgcn_mfma_f32_32x32x16_bf16(kf[2],qr[1],C0,0,0,0),   P0[10],P0[11],P0[12],P0[13], pw1[0]=PKW(P0,8), pw1[1]=PKW(P0,10), pw1); \
    VRD(5); SBAR(); GAPA(C1=__builtin_amdgcn_mfma_f32_32x32x16_bf16(kf[3],qr[1],C1,0,0,0),   P0[14],P0[15],P1[0],P1[1],   pw1[2]=PKW(P0,12),pw1[3]=PKW(P0,14), pw1); \
    VRD(2); SBAR(); GAPA(C0=__builtin_amdgcn_mfma_f32_32x32x16_bf16(kf[4],qr[2],C0,0,0,0),   P1[2],P1[3],P1[4],P1[5],     pw2[0]=PKW(P1,0), pw2[1]=PKW(P1,2), pw2); \
    VRD(6); SBAR(); GAPA(C1=__builtin_amdgcn_mfma_f32_32x32x16_bf16(kf[5],qr[2],C1,0,0,0),   P1[6],P1[7],P1[8],P1[9],     pw2[2]=PKW(P1,4), pw2[3]=PKW(P1,6), pw2); \
    VRD(3); SBAR(); GAPA(C0=__builtin_amdgcn_mfma_f32_32x32x16_bf16(kf[6],qr[3],C0,0,0,0),   P1[10],P1[11],P1[12],P1[13], pw3[0]=PKW(P1,8), pw3[1]=PKW(P1,10), pw3); \
    VRD(7); SBAR(); GAPA(C1=__builtin_amdgcn_mfma_f32_32x32x16_bf16(kf[7],qr[3],C1,0,0,0),   P1[14],P1[15],0.f,0.f,       pw3[2]=PKW(P1,12),pw3[3]=PKW(P1,14), pw3); \
    l_reg+=sacc; \
    if(GK){DMA_K((t)+3,sl_cur);} if(GV){DMA_V((t)+1,sl_next);} \
    CMASK(C0,C1,t); \
    { float a=MX3(C0[0],C0[1],C1[0]),b=MX3(C0[2],C0[3],C1[1]); a=MX3(a,C1[2],C1[3]); \
      _Pragma("unroll") for(int r=4;r<16;r+=4){a=MX3(a,C0[r],C0[r+1]);b=MX3(b,C0[r+2],C0[r+3]);a=MX3(a,C1[r],C1[r+1]);b=MX3(b,C1[r+2],C1[r+3]);} \
      float rm=__builtin_fmaxf(a,b); { auto rr=__builtin_amdgcn_permlane32_swap(__float_as_uint(rm),__float_as_uint(rm),false,false); rm=__builtin_fmaxf(__uint_as_float(rr[0]),__uint_as_float(rr[1])); } \
      resc=false; \
      if(__builtin_expect(__any(rm>(float)THRL),0)){ const float dl=__builtin_fmaxf(rm,0.f); mhat+=dl; \
        _Pragma("unroll") for(int r=0;r<16;++r){C0[r]-=dl;C1[r]-=dl;} \
        const float f=__builtin_amdgcn_exp2f(-dl); l_reg*=f; if(hi==0)wsf[r32]=f; resc=true; } } \
    SBAR(); \
    GAPB(o[0]=__builtin_amdgcn_mfma_f32_32x32x16_bf16(PAF(0),VFR(0),o[0],0,0,0), C0,0); \
    GAPB(o[1]=__builtin_amdgcn_mfma_f32_32x32x16_bf16(PAF(0),VFR(4),o[1],0,0,0), C0,4); \
    KRD(GL,0); GAPB(o[0]=__builtin_amdgcn_mfma_f32_32x32x16_bf16(PAF(1),VFR(1),o[0],0,0,0), C0,8); \
    KRD(GL,1); GAPB(o[1]=__builtin_amdgcn_mfma_f32_32x32x16_bf16(PAF(1),VFR(5),o[1],0,0,0), C0,12); \
    KRD(GL,2); GAPB(o[0]=__builtin_amdgcn_mfma_f32_32x32x16_bf16(PAF(2),VFR(2),o[0],0,0,0), C1,0); \
    KRD(GL,3); GAPB(o[1]=__builtin_amdgcn_mfma_f32_32x32x16_bf16(PAF(2),VFR(6),o[1],0,0,0), C1,4); \
    GAPB(o[0]=__builtin_amdgcn_mfma_f32_32x32x16_bf16(PAF(3),VFR(3),o[0],0,0,0), C1,8); \
    GAPB(o[1]=__builtin_amdgcn_mfma_f32_32x32x16_bf16(PAF(3),VFR(7),o[1],0,0,0), C1,12); \
    }while(0)
  int t=1;
  #undef CMASK
  #define CMASK(P0,P1,t) do{}while(0)
  for(;t+5<NT;t+=2){
    STEP(pB0,pB1,pA0,pA1,t,true,true,true);     WAIT_BAR(2); RESC(); ROT();
    STEP(pA0,pA1,pB0,pB1,t+1,true,true,true);   WAIT_BAR(2); RESC(); ROT();
  }
  #undef CMASK
  #define CMASK(P0,P1,t) do{int jb_=(t)-(NT-4); if(jb_>=0)cmask(P0,P1,jb_,qrel,hi);}while(0)
  #define ENDW(tt) do{ if((tt)+3<NT){WAIT_BAR(2);} else if((tt)+2<NT){WAIT_BAR(1);} else {WAIT_BAR(0);} }while(0)
  for(;t+1<NT;t+=2){
    STEP(pB0,pB1,pA0,pA1,t,(t+3<NT),(t+1<NT),(t+1<NT));       ENDW(t);   RESC(); ROT();
    STEP(pA0,pA1,pB0,pB1,t+1,(t+4<NT),(t+2<NT),(t+2<NT));     ENDW(t+1); RESC(); ROT();
  }
  STEP(pB0,pB1,pA0,pA1,NT-1,false,false,false); RESC();
  { float sacc=pB0[0]+pB0[1]; _Pragma("unroll") for(int r=2;r<16;++r)sacc+=pB0[r]; _Pragma("unroll") for(int r=0;r<16;++r)sacc+=pB1[r]; l_reg+=sacc;
    pw0=(u32x4){PKW(pB0,0),PKW(pB0,2),PKW(pB0,4),PKW(pB0,6)};pw1=(u32x4){PKW(pB0,8),PKW(pB0,10),PKW(pB0,12),PKW(pB0,14)};pw2=(u32x4){PKW(pB1,0),PKW(pB1,2),PKW(pB1,4),PKW(pB1,6)};pw3=(u32x4){PKW(pB1,8),PKW(pB1,10),PKW(pB1,12),PKW(pB1,14)};
    SBAR(); pv(o,vb0+sl_cur,PAF(0),PAF(1),PAF(2),PAF(3)); }
  #undef PKW
  #undef PAF
  #undef VFR
  #undef PIN
  #undef MX3
  #undef GAPA
  #undef GAPB
  #undef EX
  #undef VRD
  #undef KRD
  #undef STEP
  #undef ENDW
  #undef CINIT
  #undef CQ
  {auto rr=__builtin_amdgcn_permlane32_swap(__float_as_uint(l_reg),__float_as_uint(l_reg),false,false);l_reg=__uint_as_float(rr[0])+__uint_as_float(rr[1]);}
  if(hi==0)wsf[32+r32]=l_reg;asm volatile("s_waitcnt lgkmcnt(0)":::"memory");
  const float g0=gout[r32],g1=gout[32+r32];
  #pragma unroll
  for(int r=0;r<16;++r){ const float rl=__builtin_amdgcn_rcpf(wsf[32+crow(r,hi)]); const float y0=o[0][r]*rl,y1=o[1][r]*rl; float s=y0*y0+y1*y1;
    s+=__shfl_xor(s,1); s+=__shfl_xor(s,2); s+=__shfl_xor(s,4); s+=__shfl_xor(s,8); s+=__shfl_xor(s,16);
    const float rs=__builtin_amdgcn_rsqf(s*(1.0f/64.0f)+1e-6f); o[0][r]=y0*rs*g0; o[1][r]=y1*rs*g1; }
  bf16*Ow=O+(rowbase+q0+wid*QBLK)*DMO+h*D;
  { bf16*stg=(bf16*)(shm+LDS_OST)+wid*2048;
    #pragma unroll
    for(int r=0;r<16;++r){const int orow=crow(r,hi);
      #pragma unroll
      for(int d0=0;d0<2;++d0)stg[orow*64+d0*32+r32]=__float2bfloat16(o[d0][r]);}
    asm volatile("s_waitcnt lgkmcnt(0)":::"memory");
    #pragma unroll
    for(int i=0;i<4;++i){const int row=i*8+(lane>>3),ch=lane&7; const u32x4 v=*(const u32x4*)(stg+row*64+ch*8); ATTN_STORE16(Ow+(long)row*DMO+ch*8,v);} }
  asm volatile("s_waitcnt lgkmcnt(0)\n\ts_barrier":::"memory");
  #undef DMA_K
  #undef DMA_V
  #undef CMASK
  #undef RESC
  #undef ROT
}
constexpr int ATTN_LDS_BYTES=LDS_BYTES;
struct AttnTensors { const bf16* Q; const bf16* K; const bf16* V; bf16* O; const float* CL; const float* gout; };
#undef SBAR
#undef WAIT_BAR
}

constexpr size_t MiB = 1u << 20;
constexpr size_t WS_CTL = 0, CTL_ZERO_BYTES = 1 * MiB;
constexpr size_t WS_WIN = 2 * MiB;
constexpr size_t WS_WO  = 8 * MiB;
constexpr size_t WS_WGU = 10 * MiB;
constexpr size_t WS_WD  = 21 * MiB;
constexpr size_t WS_WPG = 27 * MiB;
constexpr size_t WS_WPP = 29 * MiB;
constexpr size_t WS_LF  = 30 * MiB;
constexpr size_t WS_CL  = 32 * MiB;
constexpr size_t WS_SSQ1 = 34 * MiB;
constexpr size_t WS_SSQ2 = 38 * MiB;
constexpr size_t WS_PB  = 48 * MiB;
constexpr size_t WS_XN  = 96 * MiB;
constexpr size_t WS_Z   = 224 * MiB;
constexpr size_t WS_Y   = 608 * MiB;
constexpr size_t WS_PROJ = 736 * MiB;
constexpr size_t WS_END = 864 * MiB;
constexpr int CW_BAR = 4096;

constexpr int RING_OFF = 0, RING_BYTES = 131072;
constexpr int LDSCTL_OFF = RING_BYTES, MISC_OFF = LDSCTL_OFF + 320;
constexpr int LDS_BYTES = 147456;
static_assert(MISC_OFF + 128 <= LDS_BYTES, "LDS map");
constexpr int NWAVES = 8;

#define GAS __attribute__((address_space(1)))
#define LAS __attribute__((address_space(3)))
typedef unsigned short bf16;
typedef unsigned v4u __attribute__((ext_vector_type(4)));
typedef float f32x4 __attribute__((ext_vector_type(4)));
typedef short bf16x8 __attribute__((ext_vector_type(8)));
typedef GAS unsigned gu32;
typedef GAS unsigned long long gu64;
#define RLX_AGENT __ATOMIC_RELAXED, __HIP_MEMORY_SCOPE_AGENT
#define LDS_WAIT() asm volatile("s_waitcnt lgkmcnt(0)" ::: "memory")
#define VM_WAIT() asm volatile("s_waitcnt vmcnt(0)" ::: "memory")
__device__ __forceinline__ unsigned long long rt() { return __builtin_amdgcn_s_memrealtime(); }
__device__ __forceinline__ unsigned f2bf(float f) { unsigned u = __builtin_bit_cast(unsigned, f); return (u + 0x7fffu + ((u >> 16) & 1u)) >> 16; }
__device__ __forceinline__ unsigned pk2(float lo, float hi) { return f2bf(lo) | (f2bf(hi) << 16); }

#define XB_TMO      128
#define XB_XCNT(j)  (256  + 64 * (j))
#define XB_XSUB(j)  (1280 + 64 * (j))
#define XB_XGEN(j)  (2304 + 64 * (j))
#define XB_TOP      3328
#define XB_TOPGEN   3392
#define XCD_BAR_WORDS 3456
#define XB_SPIN_CAP (1u << 18)

__device__ __forceinline__ unsigned xb_ld(unsigned* p)              { return __hip_atomic_load(p, __ATOMIC_RELAXED, __HIP_MEMORY_SCOPE_AGENT); }
__device__ __forceinline__ unsigned xb_add(unsigned* p, unsigned v) { return __hip_atomic_fetch_add(p, v, __ATOMIC_RELAXED, __HIP_MEMORY_SCOPE_AGENT); }
__device__ __forceinline__ unsigned xb_xcc_id() { return (unsigned)__builtin_amdgcn_s_getreg((3 << 11) | 20) & 0xFu; }
#define XB_SPIN(cond, bar) do { unsigned _sp = 0; while (cond) { __builtin_amdgcn_s_sleep(1); \
    if ((++_sp & 255u) == 0u) { if (xb_ld(&(bar)[XB_TMO])) break; if (_sp > XB_SPIN_CAP) { atomicAdd(&(bar)[XB_TMO], 1u); break; } } } } while (0)

struct XcdBarrier {
    unsigned* bar; unsigned x;
    volatile LAS unsigned* st;
};

__device__ __forceinline__ XcdBarrier xcd_barrier_post(unsigned* bar, volatile LAS unsigned* st) {
    XcdBarrier b; b.bar = bar; b.x = xb_xcc_id(); b.st = st;
    if (threadIdx.x == 0) (void)xb_add(&bar[XB_XCNT(b.x)], 1u);
    return b;
}
__device__ __forceinline__ void xcd_barrier_complete(unsigned* bar, unsigned x, unsigned& nloc, unsigned& nx) {
    const unsigned G = gridDim.x * gridDim.y * gridDim.z;
    unsigned sum, cnt, mine, sp = 0u;
    for (;;) {
        sum = 0u; cnt = 0u; mine = 0u;
#pragma unroll
        for (unsigned j = 0; j < 16; ++j) { const unsigned c = xb_ld(&bar[XB_XCNT(j)]); sum += c; cnt += (c > 0u) ? 1u : 0u; mine = (j == x) ? c : mine; }
        if (sum == G) break;
        __builtin_amdgcn_s_sleep(1);
        if ((++sp & 255u) == 0u) { if (xb_ld(&bar[XB_TMO])) break; if (sp > XB_SPIN_CAP) { atomicAdd(&bar[XB_TMO], 1u); break; } }
    }
    nloc = mine > 0u ? mine : 1u; nx = cnt > 0u ? cnt : 1u;
}

__device__ __forceinline__ void xcd_barrier(const XcdBarrier& b) {
    asm volatile("s_waitcnt vmcnt(0)" ::: "memory");
    __syncthreads();
    if (threadIdx.x == 0) {
        unsigned* bar = b.bar;
        __builtin_amdgcn_s_waitcnt(0);
        unsigned nloc = b.st[0], nx = b.st[1];
        if (nloc == 0u) { xcd_barrier_complete(bar, b.x, nloc, nx); b.st[0] = nloc; b.st[1] = nx; }
        const unsigned old = xb_add(&bar[XB_XSUB(b.x)], 1u);
        const unsigned gen = old / nloc;
        if (old + 1u == (gen + 1u) * nloc) {
            __builtin_amdgcn_fence(__ATOMIC_RELEASE, "agent");
            asm volatile("s_waitcnt vmcnt(0)" ::: "memory");
            const unsigned og = xb_add(&bar[XB_TOP], 1u);
            const unsigned tg = og / nx;
            if (og + 1u == (tg + 1u) * nx) xb_add(&bar[XB_TOPGEN], 1u);
            else XB_SPIN(xb_ld(&bar[XB_TOPGEN]) == tg, bar);
            __builtin_amdgcn_fence(__ATOMIC_ACQUIRE, "agent");
            xb_add(&bar[XB_XGEN(b.x)], 1u);
            asm volatile("s_waitcnt vmcnt(0)" ::: "memory");
        } else {
            XB_SPIN(xb_ld(&bar[XB_XGEN(b.x)]) == gen, bar);
            __builtin_amdgcn_fence(__ATOMIC_ACQUIRE, "agent");
            asm volatile("s_waitcnt vmcnt(0)" ::: "memory");
        }
    }
    __syncthreads();
}

struct Frame {
    LAS unsigned char* lds;
    volatile LAS unsigned* MISC;
    int tid, lane, wave;
    int vcu, G;
    const float *x, *p, *mix_norm, *w_in, *b_f, *conv_w, *mix_out_norm, *w_o, *ffn_norm, *w_gu, *w_d, *ple_norm, *w_pg, *b_pg, *w_pp, *final_norm;
    float* out;
    bf16 *Win_t, *Wo_t, *Wgu_t, *Wd_t, *Wpg_t, *Wpp_t;
    float *LF, *CL, *SSQ1, *SSQ2;
    bf16 *PB, *XN, *Z, *Y, *PROJ;
};
__device__ __forceinline__ float wave_sum(float v) {
#pragma unroll
    for (int o = 1; o < 64; o <<= 1) v += __shfl_xor(v, o);
    return v;
}
__device__ __forceinline__ void p0_transpose_item(const float* W, int ldw, int K, bf16* WT, int k0, int n0src, int drow0, const float* gain, LAS float* scr, int lane) {
#pragma unroll 8
    for (int i = 0; i < 32; ++i) { const int kk = 2 * i + (lane >> 5); float v = W[(size_t)(k0 + kk) * ldw + n0src + (lane & 31)]; if (gain) v *= gain[k0 + kk]; scr[kk * 33 + (lane & 31)] = v; }
    LDS_WAIT(); asm volatile("" ::: "memory");
    const int c = lane & 7;
#pragma unroll
    for (int j = 0; j < 4; ++j) { const int n = (lane >> 3) + 8 * j; const LAS float* s = scr + (8 * c) * 33 + n;
        v4u o; o.x = pk2(s[0 * 33], s[1 * 33]); o.y = pk2(s[2 * 33], s[3 * 33]); o.z = pk2(s[4 * 33], s[5 * 33]); o.w = pk2(s[6 * 33], s[7 * 33]);
        *(GAS v4u*)(WT + (size_t)(drow0 + n) * K + k0 + 8 * c) = o; }
    LDS_WAIT(); asm volatile("" ::: "memory");
}
__device__ __forceinline__ float log_sigmoid_f(float v) { return v < 0.f ? v - log1pf(expf(v)) : -log1pf(expf(-v)); }
__device__ __forceinline__ void p0_row(Frame& F, int m, const LAS float* wfT) {
    const GAS f32x4* xr = (const GAS f32x4*)(F.x + (size_t)m * DM) + F.lane;
    f32x4 v[4]; float s = 0.f;
#pragma unroll
    for (int j = 0; j < 4; ++j) { v[j] = xr[64 * j]; s += (v[j].x * v[j].x + v[j].y * v[j].y) + (v[j].z * v[j].z + v[j].w * v[j].w); }
    const float rstd = 1.f / sqrtf(wave_sum(s) * (1.f / DM) + EPS);
    float zf[8];
#pragma unroll
    for (int h = 0; h < 8; ++h) zf[h] = 0.f;
    GAS unsigned long long* o8 = (GAS unsigned long long*)(F.XN + (size_t)m * DM) + F.lane;
#pragma unroll
    for (int j = 0; j < 4; ++j) { const f32x4 g = ((const GAS f32x4*)F.mix_norm)[F.lane + 64 * j]; const f32x4 xn = v[j] * rstd * g;
        o8[64 * j] = (unsigned long long)pk2(xn.x, xn.y) | ((unsigned long long)pk2(xn.z, xn.w) << 32);
#pragma unroll
        for (int h = 0; h < 8; ++h) { const f32x4 w = *(const LAS f32x4*)(wfT + h * 1024 + 256 * j + 4 * F.lane); zf[h] += (xn.x * w.x + xn.y * w.y) + (xn.z * w.z + xn.w * w.w); } }
#pragma unroll
    for (int h = 0; h < 8; ++h) zf[h] = wave_sum(zf[h]);
    float mine = zf[0];
#pragma unroll
    for (int h = 1; h < 8; ++h) mine = (F.lane == h) ? zf[h] : mine;
    if (F.lane < 8) { const int b = m / SEQ, sp = m % SEQ; F.LF[((size_t)(b * NH + F.lane)) * SEQ + sp] = log_sigmoid_f(mine + F.b_f[F.lane]); }
}
__device__ __forceinline__ void p0_prologue(Frame& F) {
    LAS float* scr = (LAS float*)(F.lds + RING_OFF + F.wave * 16384);
    const int gw = F.vcu * NWAVES + F.wave, NGW = F.G * NWAVES;
    constexpr int I_IN = 16 * 96, I_O = 16 * 32, I_GU = 16 * 176, I_D = 44 * 32, I_PG = 16 * 32, I_PP = 4 * 32;
    constexpr int NITEMS = I_IN + I_O + I_GU + I_D + I_PG + I_PP;
    for (int it = gw; it < NITEMS; it += NGW) {
        int r = it;
        if (r < I_IN) { const int kb = r / 96, nb = r % 96; p0_transpose_item(F.w_in, INC, DM, F.Win_t, 64 * kb, 32 * nb, 32 * nb, nullptr, scr, F.lane); continue; } r -= I_IN;
        if (r < I_O)  { const int kb = r / 32, nb = r % 32; p0_transpose_item(F.w_o, DM, DM, F.Wo_t, 64 * kb, 32 * nb, 32 * nb, nullptr, scr, F.lane); continue; } r -= I_O;
        if (r < I_GU) { const int kb = r / 176, nb = r % 176, n0 = 32 * nb, up = n0 >= FF ? 1 : 0, j = n0 - up * FF; const int drow = 256 * (j / 128) + 128 * up + (j % 128);
                        p0_transpose_item(F.w_gu, 2 * FF, DM, F.Wgu_t, 64 * kb, n0, drow, F.ffn_norm, scr, F.lane); continue; } r -= I_GU;
        if (r < I_D)  { const int kb = r / 32, nb = r % 32; p0_transpose_item(F.w_d, DM, FF, F.Wd_t, 64 * kb, 32 * nb, 32 * nb, nullptr, scr, F.lane); continue; } r -= I_D;
        if (r < I_PG) { const int kb = r / 32, nb = r % 32; p0_transpose_item(F.w_pg, DM, DM, F.Wpg_t, 64 * kb, 32 * nb, 32 * nb, F.ple_norm, scr, F.lane); continue; } r -= I_PG;
        { const int kb = r / 32, nb = r % 32; p0_transpose_item(F.w_pp, DM, PLE, F.Wpp_t, 64 * kb, 32 * nb, 32 * nb, nullptr, scr, F.lane); }
    }
    __syncthreads();
    LAS float* wfT = (LAS float*)(F.lds + RING_OFF);
    for (int e = F.tid; e < 8 * DM; e += NWAVES * 64) { const int k = e >> 3, h = e & 7; wfT[h * DM + k] = F.w_in[(size_t)k * INC + 3072 + h]; }
    __syncthreads();
    for (int m = gw; m < MTOK; m += NGW) p0_row(F, m, wfT);
    { const GAS f32x4* p4 = (const GAS f32x4*)F.p; GAS unsigned long long* o8 = (GAS unsigned long long*)F.PB; const size_t n4 = (size_t)MTOK * PLE / 4;
      for (size_t i = (size_t)blockIdx.x * (NWAVES * 64) + F.tid; i < n4; i += (size_t)F.G * (NWAVES * 64)) { const f32x4 v = p4[i]; o8[i] = (unsigned long long)pk2(v.x, v.y) | ((unsigned long long)pk2(v.z, v.w) << 32); } }
    __syncthreads();
}
__device__ __forceinline__ void scan_phase(Frame& F) {
    for (int seq = blockIdx.x; seq < NB * NH; seq += F.G) {
        const float* src = F.LF + (size_t)seq * SEQ + F.tid * 8;
        const f32x4 a = *(const f32x4*)src, b = *(const f32x4*)(src + 4);
        float pr[8]; pr[0] = a.x; pr[1] = pr[0] + a.y; pr[2] = pr[1] + a.z; pr[3] = pr[2] + a.w; pr[4] = pr[3] + b.x; pr[5] = pr[4] + b.y; pr[6] = pr[5] + b.z; pr[7] = pr[6] + b.w;
        const float tot = pr[7]; float inc = tot;
#pragma unroll
        for (int o = 1; o < 64; o <<= 1) { const float t = __shfl_up(inc, o); if (F.lane >= o) inc += t; }
        LAS float* wt = (LAS float*)(F.lds + RING_OFF);
        if (F.lane == 63) wt[F.wave] = inc;
        __syncthreads();
        float woff = 0.f;
#pragma unroll
        for (int w = 0; w < NWAVES; ++w) { const float t = wt[w]; if (w < F.wave) woff += t; }
        const float excl = woff + (inc - tot);
        float* dst = F.CL + (size_t)seq * SEQ + F.tid * 8;
        *(f32x4*)dst = (f32x4){(excl + pr[0]) * LOG2E, (excl + pr[1]) * LOG2E, (excl + pr[2]) * LOG2E, (excl + pr[3]) * LOG2E};
        *(f32x4*)(dst + 4) = (f32x4){(excl + pr[4]) * LOG2E, (excl + pr[5]) * LOG2E, (excl + pr[6]) * LOG2E, (excl + pr[7]) * LOG2E};
        __syncthreads();
    }
}
__device__ __forceinline__ void conv_phase(Frame& F) {
    const int gw = F.vcu * NWAVES + F.wave, NGW = F.G * NWAVES, ch = 8 * F.lane;
    float w0[8], w1[8], w2[8], gn[8];
    { const f32x4 a0 = *(const f32x4*)(F.conv_w + ch), a1 = *(const f32x4*)(F.conv_w + ch + 4), b0 = *(const f32x4*)(F.conv_w + 512 + ch), b1 = *(const f32x4*)(F.conv_w + 512 + ch + 4),
                  c0 = *(const f32x4*)(F.conv_w + 1024 + ch), c1 = *(const f32x4*)(F.conv_w + 1024 + ch + 4), g0 = *(const f32x4*)(F.mix_out_norm + ch), g1 = *(const f32x4*)(F.mix_out_norm + ch + 4);
#pragma unroll
      for (int i = 0; i < 4; ++i) { w0[i] = a0[i]; w0[4 + i] = a1[i]; w1[i] = b0[i]; w1[4 + i] = b1[i]; w2[i] = c0[i]; w2[4 + i] = c1[i]; gn[i] = g0[i]; gn[4 + i] = g1[i]; } }
#define UNPK8(dst, PKV) do { dst[0] = pg8::bf_lo(PKV.x); dst[1] = pg8::bf_hi(PKV.x); dst[2] = pg8::bf_lo(PKV.y); dst[3] = pg8::bf_hi(PKV.y); dst[4] = pg8::bf_lo(PKV.z); dst[5] = pg8::bf_hi(PKV.z); dst[6] = pg8::bf_lo(PKV.w); dst[7] = pg8::bf_hi(PKV.w); } while (0)
    for (int chunk = gw; chunk < MTOK / 32; chunk += NGW) {
        const int r0 = chunk * 32, s0 = r0 % SEQ;
        float cu1[8], cu2[8];
#pragma unroll
        for (int i = 0; i < 8; ++i) { cu1[i] = 0.f; cu2[i] = 0.f; }
        if (s0 > 0) {
            const bf16* z2 = F.Z + (size_t)(r0 - 2) * NZ + ch; const bf16* z1 = F.Z + (size_t)(r0 - 1) * NZ + ch;
            const v4u c2w = *(const v4u*)(z2 + 512), u2w = *(const v4u*)(z2 + 1024), c1w = *(const v4u*)(z1 + 512), u1w = *(const v4u*)(z1 + 1024);
            float a[8], b[8]; UNPK8(a, c2w); UNPK8(b, u2w);
#pragma unroll
            for (int i = 0; i < 8; ++i) cu2[i] = a[i] * b[i];
            UNPK8(a, c1w); UNPK8(b, u1w);
#pragma unroll
            for (int i = 0; i < 8; ++i) cu1[i] = a[i] * b[i];
        }
#pragma unroll 4
        for (int t = 0; t < 32; ++t) {
            const bf16* zr = F.Z + (size_t)(r0 + t) * NZ + ch;
            const v4u bw = *(const v4u*)zr, cw = *(const v4u*)(zr + 512), uw = *(const v4u*)(zr + 1024);
            float gb[8], gc[8], uu[8], yv[8]; UNPK8(gb, bw); UNPK8(gc, cw); UNPK8(uu, uw);
            float ss = 0.f;
#pragma unroll
            for (int i = 0; i < 8; ++i) { const float cu0 = gc[i] * uu[i]; const float cv = w0[i] * cu2[i] + w1[i] * cu1[i] + w2[i] * cu0; yv[i] = gb[i] * cv; ss += yv[i] * yv[i]; cu2[i] = cu1[i]; cu1[i] = cu0; }
            ss += __shfl_xor(ss, 1); ss += __shfl_xor(ss, 2); ss += __shfl_xor(ss, 4);
            const float rs = 1.f / sqrtf(ss * (1.0f / 64.0f) + EPS);
            v4u o; o.x = pk2(yv[0] * rs * gn[0], yv[1] * rs * gn[1]); o.y = pk2(yv[2] * rs * gn[2], yv[3] * rs * gn[3]); o.z = pk2(yv[4] * rs * gn[4], yv[5] * rs * gn[5]); o.w = pk2(yv[6] * rs * gn[6], yv[7] * rs * gn[7]);
            *(GAS v4u*)(F.Y + (size_t)(r0 + t) * DM + ch) = o;
        }
    }
#undef UNPK8
}
__device__ __forceinline__ void final_phase(Frame& F) {
    const int gw = F.vcu * NWAVES + F.wave, NGW = F.G * NWAVES;
    f32x4 g[4];
#pragma unroll
    for (int j = 0; j < 4; ++j) g[j] = ((const GAS f32x4*)F.final_norm)[F.lane + 64 * j];
    for (int m = gw; m < MTOK; m += NGW) {
        GAS f32x4* xr = (GAS f32x4*)(F.out + (size_t)m * DM) + F.lane;
        f32x4 v[4]; float s = 0.f;
#pragma unroll
        for (int j = 0; j < 4; ++j) { v[j] = xr[64 * j]; s += (v[j].x * v[j].x + v[j].y * v[j].y) + (v[j].z * v[j].z + v[j].w * v[j].w); }
        const float rstd = 1.f / sqrtf(wave_sum(s) * (1.f / DM) + EPS);
#pragma unroll
        for (int j = 0; j < 4; ++j) xr[64 * j] = v[j] * rstd * g[j];
    }
}
__device__ __forceinline__ void attn_phase(Frame& F, char* ldsbase) {
    using namespace attn_body;
    const attn_body::bf16* Zb = (const attn_body::bf16*)F.Z;
    for (int bh = F.vcu >> 1; bh < NB * NH; bh += (F.G >> 1)) {
        const int b = bh / NH, h = bh % NH, half = F.vcu & 1;
        for (int i = 0; i < 8; ++i) {
            const int s = half + 2 * (i >> 1), qb = (i & 1) ? 15 - s : s;
            attn_unit<8>(b, h, qb, Zb + 1536, Zb + 2048, Zb + 2560, (attn_body::bf16*)F.Y + 512, F.CL + (size_t)bh * SEQ, F.mix_out_norm + 512 + h * HD, ldsbase);
        }
    }
}

struct Args { const float* in[16]; float* out; unsigned char* ws; int ph_lo, ph_hi; };
constexpr int N_PHASES = 11;
__global__ void __launch_bounds__(NWAVES * 64, 2) mega_fwd(Args args) {
    extern __shared__ __attribute__((aligned(16))) unsigned char lds[];
    Frame F;
    F.lds = (LAS unsigned char*)lds;
    F.MISC = (volatile LAS unsigned*)(F.lds + MISC_OFF);
    F.tid = threadIdx.x; F.lane = F.tid & 63; F.wave = __builtin_amdgcn_readfirstlane(F.tid >> 6);
    F.G = gridDim.x; { const int bx = blockIdx.x; F.vcu = (F.G % 8 == 0) ? (bx % 8) * (F.G / 8) + bx / 8 : bx; }
    unsigned char* ws = args.ws;
    F.x = args.in[0]; F.p = args.in[1]; F.mix_norm = args.in[2]; F.w_in = args.in[3]; F.b_f = args.in[4]; F.conv_w = args.in[5]; F.mix_out_norm = args.in[6]; F.w_o = args.in[7];
    F.ffn_norm = args.in[8]; F.w_gu = args.in[9]; F.w_d = args.in[10]; F.ple_norm = args.in[11]; F.w_pg = args.in[12]; F.b_pg = args.in[13]; F.w_pp = args.in[14]; F.final_norm = args.in[15];
    F.out = args.out;
    F.Win_t = (bf16*)(ws + WS_WIN); F.Wo_t = (bf16*)(ws + WS_WO); F.Wgu_t = (bf16*)(ws + WS_WGU); F.Wd_t = (bf16*)(ws + WS_WD); F.Wpg_t = (bf16*)(ws + WS_WPG); F.Wpp_t = (bf16*)(ws + WS_WPP);
    F.LF = (float*)(ws + WS_LF); F.CL = (float*)(ws + WS_CL); F.SSQ1 = (float*)(ws + WS_SSQ1); F.SSQ2 = (float*)(ws + WS_SSQ2);
    F.PB = (bf16*)(ws + WS_PB); F.XN = (bf16*)(ws + WS_XN); F.Z = (bf16*)(ws + WS_Z); F.Y = (bf16*)(ws + WS_Y); F.PROJ = (bf16*)(ws + WS_PROJ);
    for (int u = F.tid; u < (LDS_BYTES - LDSCTL_OFF) / 4; u += NWAVES * 64) ((LAS unsigned*)(F.lds + LDSCTL_OFF))[u] = 0u;
    __syncthreads();
    const int lo = args.ph_lo, hi = args.ph_hi;
    XcdBarrier bar; bar.bar = (unsigned*)((gu32*)(ws + WS_CTL) + CW_BAR); bar.x = 0; bar.st = nullptr;
    const bool multi = (hi - lo) > 1;
    if (multi) bar = xcd_barrier_post((unsigned*)(ws + WS_CTL) + CW_BAR, F.MISC + 8);
#ifndef PH_MASK
#define PH_MASK 0x7ff
#endif
#define IN(k) ((((PH_MASK) >> (k)) & 1) && lo <= (k) && (k) < hi)
#define SEAM(k) do { if (IN(k) && IN((k) + 1)) xcd_barrier(bar); } while (0)

    if (IN(0)) { p0_prologue(F); } SEAM(0);
    if (IN(1)) { scan_phase(F); }
    if (IN(2)) {
        pg8::Gemm g{F.XN, F.Win_t, MTOK, NZ, DM}; pg8::StaticOrder S; S.init(MTOK, NZ, F.G, (int)blockIdx.x);
        pg8::EpiBf16Plain E{F.Z, NZ, 6, 8, QSCALE};
        pg8::gemm_phase<pg8::EpiBf16Plain, pg8::StaticOrder, PG8_ALIGN, PG8_SP2>(F.lds + RING_OFF, g, S, E);
    } SEAM(2);
    if (IN(3)) { attn_phase(F, (char*)lds + RING_OFF); }
    if (IN(4)) { conv_phase(F); } SEAM(4);
    if (IN(5)) {
        pg8::Gemm g{F.Y, F.Wo_t, MTOK, DM, DM}; pg8::StaticOrder S; S.init(MTOK, DM, F.G, (int)blockIdx.x);
        pg8::EpiRes<true> E{F.x, nullptr, F.XN, F.SSQ1};
        pg8::gemm_phase<pg8::EpiRes<true>, pg8::StaticOrder, PG8_ALIGN, PG8_SP2>(F.lds + RING_OFF, g, S, E);
    } SEAM(5);
    if (IN(6)) {
        pg8::Gemm g{F.XN, F.Wgu_t, MTOK, 2 * FF, DM}; pg8::StaticOrder S; S.init(MTOK, 2 * FF, F.G, (int)blockIdx.x);
        pg8::EpiSwiglu E{F.Z, F.SSQ1};
        pg8::gemm_phase<pg8::EpiSwiglu, pg8::StaticOrder, PG8_ALIGN, PG8_SP2>(F.lds + RING_OFF, g, S, E);
    } SEAM(6);
    if (IN(7)) {
        pg8::Gemm g{F.Z, F.Wd_t, MTOK, DM, FF}; pg8::StaticOrder S; S.init(MTOK, DM, F.G, (int)blockIdx.x);
        pg8::EpiRes<false> E{nullptr, F.XN, F.Y, F.SSQ2};
        pg8::gemm_phase<pg8::EpiRes<false>, pg8::StaticOrder, PG8_ALIGN, PG8_SP2>(F.lds + RING_OFF, g, S, E);
    }
    if (IN(8)) {
        pg8::Gemm g{F.PB, F.Wpp_t, MTOK, DM, PLE}; pg8::StaticOrder S; S.init(MTOK, DM, F.G, (int)blockIdx.x);
        pg8::EpiBf16Plain E{F.PROJ, DM, 0, 0, 1.f};
        pg8::gemm_phase<pg8::EpiBf16Plain, pg8::StaticOrder, PG8_ALIGN, PG8_SP2>(F.lds + RING_OFF, g, S, E);
    } SEAM(8);
    if (IN(9)) {
        pg8::Gemm g{F.Y, F.Wpg_t, MTOK, DM, DM}; pg8::StaticOrder S; S.init(MTOK, DM, F.G, (int)blockIdx.x);
        pg8::EpiPle E{F.Y, F.PROJ, F.SSQ2, F.b_pg, F.out};
        pg8::gemm_phase<pg8::EpiPle, pg8::StaticOrder, PG8_ALIGN, PG8_SP2>(F.lds + RING_OFF, g, S, E);
    } SEAM(9);
    if (IN(10)) { final_phase(F); }
#undef IN
#undef SEAM
}

namespace naive {
typedef short bf16x8 __attribute__((ext_vector_type(8)));
typedef float f32x4 __attribute__((ext_vector_type(4)));
__device__ __forceinline__ float bf2f(unsigned short h) { return __uint_as_float((unsigned)h << 16); }
__device__ __forceinline__ unsigned short f2bf16(float f) { return (unsigned short)f2bf(f); }
struct NArgs { const unsigned short* A; const unsigned short* Bt; int M, N, K; int kind;
               const float* X; const unsigned short* Hin; unsigned short* Hout; const float* SSQ; const unsigned short* PROJ; const float* bg; float* OUT; };
__device__ __forceinline__ float nrstd(const float* ssq, int row) { float s = 0.f; for (int i = 0; i < 16; ++i) s += ssq[(size_t)row * 16 + i]; return 1.f / sqrtf(s * (1.f / 1024.f) + 1e-6f); }
__device__ __forceinline__ float nsig(float v) { return 1.f / (1.f + expf(-v)); }
__global__ void __launch_bounds__(256) naive_gemm(NArgs a) {
    const int lane = threadIdx.x & 63, w = threadIdx.x >> 6, fr = lane & 15, fq = lane >> 4;
    const int m0 = blockIdx.y * 64 + 16 * w, n0 = blockIdx.x * 64;
    f32x4 acc[4], acc2[4];
    for (int j = 0; j < 4; ++j) { acc[j] = (f32x4){0.f, 0.f, 0.f, 0.f}; acc2[j] = (f32x4){0.f, 0.f, 0.f, 0.f}; }
    const bool dual = a.kind == 6;
    for (int k0 = 0; k0 < a.K; k0 += 32) {
        const bf16x8 af = *(const bf16x8*)(a.A + (size_t)(m0 + fr) * a.K + k0 + 8 * fq);
        for (int j = 0; j < 4; ++j) {
            const int col = n0 + 16 * j + fr;
            int brow = col;
            if (dual) brow = 256 * (col / 128) + (col % 128);
            const bf16x8 bf = *(const bf16x8*)(a.Bt + (size_t)brow * a.K + k0 + 8 * fq);
            acc[j] = __builtin_amdgcn_mfma_f32_16x16x32_bf16(af, bf, acc[j], 0, 0, 0);
            if (dual) { const bf16x8 bf2 = *(const bf16x8*)(a.Bt + (size_t)(brow + 128) * a.K + k0 + 8 * fq); acc2[j] = __builtin_amdgcn_mfma_f32_16x16x32_bf16(af, bf2, acc2[j], 0, 0, 0); }
        }
    }
    for (int j = 0; j < 4; ++j)
        for (int r = 0; r < 4; ++r) {
            const int row = m0 + 4 * fq + r, col = n0 + 16 * j + fr; const float v = acc[j][r];
            switch (a.kind) {
                case 2: a.Hout[(size_t)row * 3072 + col] = f2bf16(v * ((col >= 1536 && col < 2048) ? QSCALE : 1.f)); break;
                case 5: a.Hout[(size_t)row * 1024 + col] = f2bf16(a.X[(size_t)row * 1024 + col] + v); break;
                case 6: { const float rs = nrstd(a.SSQ, row), g = v * rs, u = acc2[j][r] * rs; a.Hout[(size_t)row * 2816 + col] = f2bf16(g * nsig(g) * u); } break;
                case 7: a.Hout[(size_t)row * 1024 + col] = f2bf16(bf2f(a.Hin[(size_t)row * 1024 + col]) + v); break;
                case 8: a.Hout[(size_t)row * 1024 + col] = f2bf16(v); break;
                case 9: { const float rs = nrstd(a.SSQ, row); a.OUT[(size_t)row * 1024 + col] = bf2f(a.Hin[(size_t)row * 1024 + col]) + nsig(v * rs + a.bg[col]) * bf2f(a.PROJ[(size_t)row * 1024 + col]); } break;
            }
        }
}
__global__ void __launch_bounds__(256) naive_ssq(const unsigned short* H, float* SSQ) {
    const int row = blockIdx.x * 4 + (threadIdx.x >> 6), lane = threadIdx.x & 63; float s = 0.f;
    for (int c = lane; c < 1024; c += 64) { const float v = bf2f(H[(size_t)row * 1024 + c]); s += v * v; }
    for (int o = 1; o < 64; o <<= 1) s += __shfl_xor(s, o);
    if (lane < 16) SSQ[(size_t)row * 16 + lane] = lane == 0 ? s : 0.f;
}
__global__ void __launch_bounds__(64) naive_attn(const unsigned short* Z, const float* CL, const float* gout_all, unsigned short* Y) {
    __shared__ float Ks[64][64]; __shared__ float Vs[64][64]; __shared__ float Sc[64][64];
    const int tid = threadIdx.x, qblk = blockIdx.x % (SEQ / 64), bh = blockIdx.x / (SEQ / 64), b = bh / NH, h = bh % NH;
    const int t = qblk * 64 + tid; const size_t row = (size_t)b * SEQ + t;
    float q[64], o[64];
#pragma unroll
    for (int d = 0; d < 64; ++d) { q[d] = bf2f(Z[row * 3072 + 1536 + h * 64 + d]); o[d] = 0.f; }
    const float* cl = CL + (size_t)bh * SEQ; const float clq = cl[t];
    float m_run = -INFINITY, l = 0.f;
    for (int kt = 0; kt <= qblk; ++kt) {
        __syncthreads();
        { const size_t kr = (size_t)b * SEQ + kt * 64 + tid;
#pragma unroll
          for (int d = 0; d < 64; ++d) { Ks[tid][d] = bf2f(Z[kr * 3072 + 2048 + h * 64 + d]); Vs[tid][d] = bf2f(Z[kr * 3072 + 2560 + h * 64 + d]); } }
        __syncthreads();
        float tmax = -INFINITY;
        for (int j = 0; j < 64; ++j) { const int key = kt * 64 + j; float s = 0.f;
#pragma unroll
            for (int d = 0; d < 64; ++d) s += q[d] * Ks[j][d];
            s += clq - cl[key]; if (key > t) s = -INFINITY; Sc[j][tid] = s; tmax = fmaxf(tmax, s); }
        const float m_new = fmaxf(m_run, tmax), sc = exp2f(m_run - m_new); l *= sc;
#pragma unroll
        for (int d = 0; d < 64; ++d) o[d] *= sc;
        m_run = m_new;
        for (int j = 0; j < 64; ++j) { const float p = exp2f(Sc[j][tid] - m_new); l += p;
#pragma unroll
            for (int d = 0; d < 64; ++d) o[d] += p * Vs[j][d]; }
    }
    float ss = 0.f; const float rl = 1.f / l;
#pragma unroll
    for (int d = 0; d < 64; ++d) { o[d] *= rl; ss += o[d] * o[d]; }
    const float rs = 1.f / sqrtf(ss * (1.f / 64.f) + 1e-6f);
#pragma unroll
    for (int d = 0; d < 64; ++d) Y[row * 1024 + 512 + h * 64 + d] = f2bf16(o[d] * rs * gout_all[512 + h * 64 + d]);
}
}

extern "C" void kernel_launch(void* const* d_in, const int* in_sizes, int n_in, void* d_out, int out_size, void* d_ws, size_t ws_size, hipStream_t stream) {
    static int grid = 0;
    if (grid == 0) {
        if (n_in != 16 || in_sizes[0] != MTOK * DM || out_size != MTOK * DM || ws_size < WS_END) { fprintf(stderr, "kernel_launch: unexpected problem shape (n_in %d, in0 %d, out %d, ws %zu); nothing launched\n", n_in, n_in > 0 ? in_sizes[0] : -1, out_size, ws_size); grid = -1; return; }
        int dev = 0, cus = 0;
        if (hipGetDevice(&dev) != hipSuccess || hipDeviceGetAttribute(&cus, hipDeviceAttributeMultiprocessorCount, dev) != hipSuccess) { fprintf(stderr, "kernel_launch: device query failed\n"); grid = -1; return; }
        if (hipFuncSetAttribute((const void*)mega_fwd, hipFuncAttributeMaxDynamicSharedMemorySize, LDS_BYTES) != hipSuccess) { fprintf(stderr, "kernel_launch: hipFuncSetAttribute failed\n"); grid = -1; return; }
        (void)hipGetLastError();
        grid = cus;
        if (grid != 256) fprintf(stderr, "kernel_launch: note: %d CUs\n", grid);
    }
    if (grid < 0) return;
    if (hipMemsetAsync((char*)d_ws + WS_CTL, 0, CTL_ZERO_BYTES, stream) != hipSuccess) { fprintf(stderr, "kernel_launch: memset failed\n"); return; }
    Args a{};
    for (int i = 0; i < 16; ++i) a.in[i] = (const float*)d_in[i];
    a.out = (float*)d_out; a.ws = (unsigned char*)d_ws;
    unsigned char* ws = (unsigned char*)d_ws;
    auto mega = [&](int lo, int hi) { a.ph_lo = lo; a.ph_hi = hi; hipLaunchKernelGGL(mega_fwd, dim3(grid), dim3(NWAVES * 64), LDS_BYTES, stream, a); };
#if CFG_ONE_LAUNCH
    mega(0, N_PHASES);
#else
    auto ngemm = [&](int kind) {
        naive::NArgs n{}; n.kind = kind; n.M = MTOK;
        unsigned short* XN = (unsigned short*)(ws + WS_XN); unsigned short* Zp = (unsigned short*)(ws + WS_Z); unsigned short* Yp = (unsigned short*)(ws + WS_Y); unsigned short* PR = (unsigned short*)(ws + WS_PROJ);
        int ncols = 0;
        switch (kind) {
            case 2: n.A = XN; n.Bt = (unsigned short*)(ws + WS_WIN); n.K = DM; n.Hout = Zp; ncols = NZ; break;
            case 5: n.A = Yp; n.Bt = (unsigned short*)(ws + WS_WO); n.K = DM; n.X = (const float*)d_in[0]; n.Hout = XN; ncols = DM; break;
            case 6: n.A = XN; n.Bt = (unsigned short*)(ws + WS_WGU); n.K = DM; n.SSQ = (const float*)(ws + WS_SSQ1); n.Hout = Zp; ncols = FF; break;
            case 7: n.A = Zp; n.Bt = (unsigned short*)(ws + WS_WD); n.K = FF; n.Hin = XN; n.Hout = Yp; ncols = DM; break;
            case 8: n.A = (unsigned short*)(ws + WS_PB); n.Bt = (unsigned short*)(ws + WS_WPP); n.K = PLE; n.Hout = PR; ncols = DM; break;
            case 9: n.A = Yp; n.Bt = (unsigned short*)(ws + WS_WPG); n.K = DM; n.Hin = Yp; n.PROJ = PR; n.SSQ = (const float*)(ws + WS_SSQ2); n.bg = (const float*)d_in[13]; n.OUT = (float*)d_out; ncols = DM; break;
        }
        n.N = ncols;
        hipLaunchKernelGGL(naive::naive_gemm, dim3(ncols / 64, MTOK / 64), dim3(256), 0, stream, n);
        if (kind == 5) hipLaunchKernelGGL(naive::naive_ssq, dim3(MTOK / 4), dim3(256), 0, stream, (const unsigned short*)XN, (float*)(ws + WS_SSQ1));
        if (kind == 7) hipLaunchKernelGGL(naive::naive_ssq, dim3(MTOK / 4), dim3(256), 0, stream, (const unsigned short*)Yp, (float*)(ws + WS_SSQ2));
    };
    for (int ph = 0; ph < N_PHASES; ++ph) {
        const bool is_gemm = (ph == 2 || ph == 5 || ph == 6 || ph == 7 || ph == 8 || ph == 9);
        if (is_gemm && ((CFG_NAIVE_GEMM >> ph) & 1)) { ngemm(ph); continue; }
        if (ph == 3 && CFG_NAIVE_ATTN) { hipLaunchKernelGGL(naive::naive_attn, dim3(NB * NH * (SEQ / 64)), dim3(64), 0, stream, (const unsigned short*)(ws + WS_Z), (const float*)(ws + WS_CL), (const float*)d_in[6], (unsigned short*)(ws + WS_Y)); continue; }
        mega(ph, ph + 1);
    }
#endif
    const hipError_t le = hipPeekAtLastError();
    if (le != hipSuccess) fprintf(stderr, "kernel_launch: launch failed: %s\n", hipGetErrorName(le));
}
```

```cpp
#include <hip/hip_runtime.h>
#include <hip/hip_bf16.h>
#include <cstdio>
#include <cstdint>
#include <cmath>

constexpr int NB = 16, SEQ = 4096, DM = 1024, MTOK = NB * SEQ, NH = 8, HD = 64, FF = 2816, PLE = 256, NZ = 3072, INC = 3080;
constexpr float EPS = 1e-6f;
constexpr float LOG2E = 1.4426950408889634f;
constexpr float QSCALE = 0.125f * 1.4426950408889634f;
#ifndef CFG_NAIVE_GEMM
#define CFG_NAIVE_GEMM 0
#endif
#ifndef CFG_NAIVE_ATTN
#define CFG_NAIVE_ATTN 0
#endif
#ifndef CFG_ONE_LAUNCH
#define CFG_ONE_LAUNCH 1
#endif

namespace pg8 {
#define PG8_LAS __attribute__((address_space(3)))
typedef unsigned short bf16_t;
typedef short bf16x8 __attribute__((ext_vector_type(8)));
typedef float f32x4 __attribute__((ext_vector_type(4)));
typedef unsigned u32x4 __attribute__((ext_vector_type(4)));
constexpr int BM = 256, BK = 64, HALF = 128, HTB = HALF * BK * 2  , STAGE_BYTES = 8 * HTB, NXCD = 8, WGM = 8;

__host__ __device__ __forceinline__ int lds_byte(int r, int c) { const int st = (r >> 4) * 2 + (c >> 5), rr = r & 15, cc = c & 31, ob = rr * 64 + cc * 2; return st * 1024 + (ob ^ (((ob >> 9) & 1) << 5)); }
__host__ __device__ __forceinline__ void stage_rc(int b, int& R, int& C) { const int st = b / 1024, sb = b % 1024, swz = sb ^ (((sb >> 9) & 1) << 5); R = (st >> 1) * 16 + swz / 64; C = (st & 1) * 32 + (swz % 64) / 2; }
__host__ __device__ __forceinline__ int perm32(int rho) { const int n = rho >> 4, i = rho & 15; return 8 * (i >> 2) + 4 * n + (i & 3); }

struct Unit { int pm, pn; };
struct Gemm { const bf16_t* A; const bf16_t* Bt; int M, N, K; };

struct StaticOrder {
    int nM, nN, nwg, G, c, rev;
    __host__ __device__ void init(int M, int N, int G_, int c_) { nM = M / BM; nN = N / BM; nwg = nM * nN; G = G_; c = c_; rev = 0; }
    __host__ __device__ bool next(int i, Unit& u) const {
        const int nr = (nwg + G - 1) / G; if (i >= nr) return false;
        const long L = (long)(rev ? nr - 1 - i : i) * G + c; if (L >= nwg) return false;
        int wgid = (int)L; { const int q = nwg / NXCD, r = nwg % NXCD, xcd = wgid % NXCD, off = wgid / NXCD; wgid = (xcd < r ? xcd * (q + 1) : r * (q + 1) + (xcd - r) * q) + off; }
        const int nig = WGM * nN, gid = wgid / nig, fm = gid * WGM, gsz = (nM - fm) < WGM ? (nM - fm) : WGM;
        u.pm = fm + ((wgid % nig) % gsz); u.pn = (wgid % nig) / gsz; return true;
    }
    __device__ __forceinline__ void a_ready(const Unit&) const {}
    __device__ __forceinline__ void done(const Unit&) const {}
};

__device__ __forceinline__ unsigned cvt_pk_bf16(float lo, float hi) { unsigned r; asm volatile("v_cvt_pk_bf16_f32 %0, %1, %2" : "=v"(r) : "v"(lo), "v"(hi)); return r; }
typedef float f32x2 __attribute__((ext_vector_type(2)));
typedef unsigned u32x2 __attribute__((ext_vector_type(2)));
__device__ __forceinline__ float bf_lo(unsigned w) { return __uint_as_float(w << 16); }
__device__ __forceinline__ float bf_hi(unsigned w) { return __uint_as_float(w & 0xffff0000u); }
__device__ __forceinline__ int fresh_lane() { int l; asm volatile("v_mbcnt_lo_u32_b32 %0, -1, 0\n\tv_mbcnt_hi_u32_b32 %0, -1, %0" : "=v"(l)); return l; }
#define PG8_DPP(x, ctrl) __int_as_float(__builtin_amdgcn_update_dpp(0, __float_as_int(x), (ctrl), 0xf, 0xf, true))
__device__ __forceinline__ float sum_fq(float s) {
    s += __int_as_float(__builtin_amdgcn_ds_swizzle(__float_as_int(s), (16 << 10) | 0x1f));
    auto rr = __builtin_amdgcn_permlane32_swap(__float_as_uint(s), __float_as_uint(s), false, false); return __uint_as_float(rr[0]) + __uint_as_float(rr[1]); }
__device__ __forceinline__ float max_row16(float s) {
    s = fmaxf(s, PG8_DPP(s, 0xB1)); s = fmaxf(s, PG8_DPP(s, 0x4E)); s = fmaxf(s, PG8_DPP(s, 0x141)); s = fmaxf(s, PG8_DPP(s, 0x140)); return s; }
__device__ __forceinline__ float sum_row8(float s) {
    s += PG8_DPP(s, 0xB1); s += PG8_DPP(s, 0x4E); s += PG8_DPP(s, 0x141); return s; }
__device__ __forceinline__ float sq8(const u32x4 w) {
    float s = 0.f;
    s += bf_lo(w.x) * bf_lo(w.x); s += bf_hi(w.x) * bf_hi(w.x); s += bf_lo(w.y) * bf_lo(w.y); s += bf_hi(w.y) * bf_hi(w.y);
    s += bf_lo(w.z) * bf_lo(w.z); s += bf_hi(w.z) * bf_hi(w.z); s += bf_lo(w.w) * bf_lo(w.w); s += bf_hi(w.w) * bf_hi(w.w);
    return s;
}
__device__ __forceinline__ u32x4 pack8(const f32x4 v0, const f32x4 v1) { u32x4 w; w.x = cvt_pk_bf16(v0[0], v0[1]); w.y = cvt_pk_bf16(v0[2], v0[3]); w.z = cvt_pk_bf16(v1[0], v1[1]); w.w = cvt_pk_bf16(v1[2], v1[3]); return w; }
__device__ __forceinline__ float row_rstd(const float* ssq, int row) {
    const f32x4* p = (const f32x4*)(ssq + (size_t)row * 16);
    const f32x4 a = p[0], b = p[1], c = p[2], d = p[3];
    const float s = ((a[0] + a[1]) + (a[2] + a[3])) + ((b[0] + b[1]) + (b[2] + b[3])) + ((c[0] + c[1]) + (c[2] + c[3])) + ((d[0] + d[1]) + (d[2] + d[3]));
    return __builtin_amdgcn_rsqf(s * (1.0f / 1024.0f) + 1e-6f);
}
__device__ __forceinline__ float sigmoid_f(float v) { return __builtin_amdgcn_rcpf(1.0f + __builtin_amdgcn_exp2f(-1.4426950408889634f * v)); }

__device__ __forceinline__ u32x4 swap_fr8(const u32x4 v) { u32x4 r;
    r.x = (unsigned)__builtin_amdgcn_update_dpp(0, (int)v.x, 0x128, 0xf, 0xf, false); r.y = (unsigned)__builtin_amdgcn_update_dpp(0, (int)v.y, 0x128, 0xf, 0xf, false);
    r.z = (unsigned)__builtin_amdgcn_update_dpp(0, (int)v.z, 0x128, 0xf, 0xf, false); r.w = (unsigned)__builtin_amdgcn_update_dpp(0, (int)v.w, 0x128, 0xf, 0xf, false); return r; }
__device__ __forceinline__ void full_line_pair(const u32x4 c0, const u32x4 c1, bool lo, u32x4& s0, u32x4& s1) {
    u32x4 snd; snd.x = lo ? c1.x : c0.x; snd.y = lo ? c1.y : c0.y; snd.z = lo ? c1.z : c0.z; snd.w = lo ? c1.w : c0.w;
    const u32x4 rcv = swap_fr8(snd);
    s0.x = lo ? c0.x : rcv.x; s0.y = lo ? c0.y : rcv.y; s0.z = lo ? c0.z : rcv.z; s0.w = lo ? c0.w : rcv.w;
    s1.x = lo ? rcv.x : c1.x; s1.y = lo ? rcv.y : c1.y; s1.z = lo ? rcv.z : c1.z; s1.w = lo ? rcv.w : c1.w;
}
struct EpiBf16Plain {
    static constexpr bool PERM = true, AFTER_DRAIN = false, BSPLIT = true, RESID_INIT = false;
    bf16_t* O; int ldc; int sc_lo, sc_hi; float scale; unsigned* KN; unsigned* QN; bf16_t* CU;
    __device__ __forceinline__ void operator()(const f32x4 (&acc)[2][2][4][2], const Unit& u, int wr, int wc, int fr, int fq) const {
        const bool lo = fr < 8;
        const int rowb = u.pm * BM + wr * 64 + (fr & 7), colb = u.pn * BM + wc * 64 + (lo ? 0 : 32) + 8 * fq;
        const float sc = (u.pn >= sc_lo && u.pn < sc_hi) ? scale : 1.f;
        const bool norms = KN != nullptr && u.pn >= 6 && u.pn < 10;
        if (CU != nullptr && u.pn >= 2 && u.pn < 6) {
            const int row0 = u.pm * BM + wr * 64 + fr, ch0 = (u.pn - 2) * HALF + wc * 32 + 8 * fq;
#pragma unroll
            for (int ai = 0; ai < 2; ++ai)
#pragma unroll
                for (int m = 0; m < 4; ++m) *(u32x4*)(CU + (size_t)(row0 + ai * HALF + m * 16) * 512 + ch0) = pack8(acc[ai][0][m][0] * acc[ai][1][m][0], acc[ai][0][m][1] * acc[ai][1][m][1]);
            return; }
        float qmx0 = 0.f, qmx1 = 0.f;
#pragma unroll
        for (int ai = 0; ai < 2; ++ai) { float mx0 = 0.f, mx1 = 0.f;
#pragma unroll
            for (int m = 0; m < 4; ++m) { bf16_t* rowp = O + (size_t)(rowb + ai * HALF + m * 16) * ldc + colb;
                const u32x4 c0 = pack8(acc[ai][0][m][0] * sc, acc[ai][0][m][1] * sc), c1 = pack8(acc[ai][1][m][0] * sc, acc[ai][1][m][1] * sc);
                if (norms) { const float a = sum_fq(sq8(c0)), b = sum_fq(sq8(c1)); mx0 = fmaxf(mx0, a); mx1 = fmaxf(mx1, b); }
                u32x4 s0, s1; full_line_pair(c0, c1, lo, s0, s1);
                *(u32x4*)rowp = s0; *(u32x4*)(rowp + (size_t)8 * ldc) = s1; }
            if (norms) {
                mx0 = max_row16(mx0); mx1 = max_row16(mx1);
                if (u.pn >= 8) { const int r64 = (u.pm * BM + ai * HALF + wr * 64) >> 6, bb = r64 >> 6, tile = r64 & 63, head = 4 * (u.pn & 1) + wc;
                    if (fr == 0 && fq == 0) { atomicMax(KN + ((size_t)(bb * 8 + head) * 64 + tile) * 2, __float_as_uint(mx0)); atomicMax(KN + ((size_t)(bb * 8 + head) * 64 + tile) * 2 + 1, __float_as_uint(mx1)); } }
                else { qmx0 = fmaxf(qmx0, mx0); qmx1 = fmaxf(qmx1, mx1); } } }
        if (norms && u.pn < 8 && fr == 0 && fq == 0) { const int bb = u.pm >> 4, qb = u.pm & 15, head = 4 * (u.pn & 1) + wc;
            atomicMax(QN + ((size_t)(bb * 8 + head) * 16 + qb) * 2, __float_as_uint(qmx0)); atomicMax(QN + ((size_t)(bb * 8 + head) * 16 + qb) * 2 + 1, __float_as_uint(qmx1)); }
    }
};
__device__ __forceinline__ void rows_rstd(const float* ssq, int row0, float (&rs)[2][4]) {
#pragma unroll
    for (int ai = 0; ai < 2; ++ai) { f32x4 t[4][4];
#pragma unroll
        for (int m = 0; m < 4; ++m) { const f32x4* p = (const f32x4*)(ssq + (size_t)(row0 + ai * HALF + m * 16) * 16);
#pragma unroll
            for (int q = 0; q < 4; ++q) t[m][q] = p[q]; }
#pragma unroll
        for (int m = 0; m < 4; ++m) { const f32x4 a = (t[m][0] + t[m][1]) + (t[m][2] + t[m][3]); rs[ai][m] = __builtin_amdgcn_rsqf(((a[0] + a[1]) + (a[2] + a[3])) * (1.0f / 1024.0f) + 1e-6f); } }
}
template <bool XF32> struct EpiRes {
    static constexpr bool PERM = true, AFTER_DRAIN = false, BSPLIT = false, RESID_INIT = true;
    struct Raw { u32x4 r[8][2]; float irs[8]; };
    const bf16_t* Hin; bf16_t* H; float* SSQ; const float* IRS;
    __device__ __forceinline__ void load_base(Raw& R, const Unit& u, int wr, int wc, int fr, int fq) const {
        const int row0 = u.pm * BM + wr * 64 + fr, col0 = u.pn * BM + wc * 32 + 8 * fq;
#pragma unroll
        for (int it = 0; it < 8; ++it) { const int row = row0 + (it >> 2) * HALF + (it & 3) * 16; const size_t off = (size_t)row * 1024 + col0;
            R.irs[it] = XF32 ? IRS[row] : 1.f;
#pragma unroll
            for (int bj = 0; bj < 2; ++bj) R.r[it][bj] = *(const u32x4*)(Hin + off + bj * HALF); }
    }
    __device__ __forceinline__ void init_acc(f32x4 (&acc)[2][2][4][2], const Raw& R) const {
#pragma unroll
        for (int it = 0; it < 8; ++it) { const int ai = it >> 2, m = it & 3;
#pragma unroll
            for (int bj = 0; bj < 2; ++bj) { const u32x4 hw = R.r[it][bj];
                f32x4 b0v = (f32x4){bf_lo(hw.x), bf_hi(hw.x), bf_lo(hw.y), bf_hi(hw.y)}, b1v = (f32x4){bf_lo(hw.z), bf_hi(hw.z), bf_lo(hw.w), bf_hi(hw.w)};
                if (XF32) { b0v = b0v * R.irs[it]; b1v = b1v * R.irs[it]; }
                acc[ai][bj][m][0] = b0v; acc[ai][bj][m][1] = b1v; } }
    }
    __device__ __forceinline__ void operator()(const f32x4 (&acc)[2][2][4][2], const Unit& u, int wr, int wc, int fr, int fq) const {
        const int row0 = u.pm * BM + wr * 64 + fr, col0 = u.pn * BM + wc * 32 + 8 * fq;
#pragma unroll
        for (int it = 0; it < 8; ++it) { const int ai = it >> 2, m = it & 3; const int row = row0 + ai * HALF + m * 16; const size_t off = (size_t)row * 1024 + col0; float s = 0.f;
#pragma unroll
            for (int bj = 0; bj < 2; ++bj) { const u32x4 w = pack8(acc[ai][bj][m][0], acc[ai][bj][m][1]); *(u32x4*)(H + off + bj * HALF) = w; s += sq8(w); }
            s = sum_fq(s);
            if (fq == 0) SSQ[(size_t)row * 16 + u.pn * 4 + wc] = s; }
    }
};
struct EpiSwiglu {
    static constexpr bool PERM = true, AFTER_DRAIN = false, BSPLIT = false, RESID_INIT = false;
    bf16_t* ACT; const float* SSQ; const PG8_LAS float* RT;
    __device__ __forceinline__ void operator()(const f32x4 (&acc)[2][2][4][2], const Unit& u, int wr, int wc, int fr, int fq) const {
        const int row0 = u.pm * BM + wr * 64 + fr, col0 = u.pn * HALF + wc * 32 + 8 * fq;
        float rs[2][4];
        if (RT) { const PG8_LAS float* t = RT + ((u.pm >> 3) & 3) * 256 + wr * 64 + fr;
#pragma unroll
            for (int ai = 0; ai < 2; ++ai)
#pragma unroll
                for (int m = 0; m < 4; ++m) rs[ai][m] = t[ai * HALF + m * 16]; }
        else rows_rstd(SSQ, row0, rs);
#pragma unroll
        for (int ai = 0; ai < 2; ++ai)
#pragma unroll
            for (int m = 0; m < 4; ++m) { const int row = row0 + ai * HALF + m * 16; const float r = rs[ai][m];
                f32x4 o[2];
#pragma unroll
                for (int n = 0; n < 2; ++n) { const f32x4 g = acc[ai][0][m][n] * r, up = acc[ai][1][m][n] * r;
                    const f32x4 x = g * (-1.4426950408889634f); f32x4 d;
#pragma unroll
                    for (int i = 0; i < 4; ++i) d[i] = __builtin_amdgcn_exp2f(x[i]);
                    d = d + 1.0f;
#pragma unroll
                    for (int i = 0; i < 4; ++i) d[i] = __builtin_amdgcn_rcpf(d[i]);
                    o[n] = (g * d) * up; }
                *(u32x4*)(ACT + (size_t)row * 2816 + col0) = pack8(o[0], o[1]); }
    }
};
struct EpiPle {
    static constexpr bool PERM = true, AFTER_DRAIN = false, BSPLIT = false, RESID_INIT = false;
    const bf16_t* H2; const bf16_t* PROJ; const float* SSQ; const float* bg; bf16_t* OUT; const PG8_LAS float* RT;
    __device__ __forceinline__ void operator()(const f32x4 (&acc)[2][2][4][2], const Unit& u, int wr, int wc, int fr, int fq) const {
        const int row0 = u.pm * BM + wr * 64 + fr, col0 = u.pn * BM + wc * 32 + 8 * fq;
#pragma unroll
        for (int ai = 0; ai < 2; ++ai) {
            float rs[4];
            if (RT) { const PG8_LAS float* tt = RT + ((u.pm >> 3) & 3) * 256 + ai * HALF + wr * 64 + fr;
#pragma unroll
                for (int m = 0; m < 4; ++m) rs[m] = tt[m * 16]; }
            else { f32x4 t[4][4];
#pragma unroll
              for (int m = 0; m < 4; ++m) { const f32x4* p = (const f32x4*)(SSQ + (size_t)(row0 + ai * HALF + m * 16) * 16);
#pragma unroll
                  for (int q = 0; q < 4; ++q) t[m][q] = p[q]; }
#pragma unroll
              for (int m = 0; m < 4; ++m) { const f32x4 a = (t[m][0] + t[m][1]) + (t[m][2] + t[m][3]); rs[m] = __builtin_amdgcn_rsqf(((a[0] + a[1]) + (a[2] + a[3])) * (1.0f / 1024.0f) + 1e-6f); } }
            asm volatile("" ::: "memory");
            u32x4 hb[4][2], pb[4][2]; f32x4 bv[2][2];
#pragma unroll
            for (int m = 0; m < 4; ++m) { const size_t off = (size_t)(row0 + ai * HALF + m * 16) * 1024 + col0;
#pragma unroll
                for (int bj = 0; bj < 2; ++bj) { hb[m][bj] = *(const u32x4*)(H2 + off + bj * HALF); pb[m][bj] = *(const u32x4*)(PROJ + off + bj * HALF); } }
#pragma unroll
            for (int bj = 0; bj < 2; ++bj)
#pragma unroll
                for (int n = 0; n < 2; ++n) bv[bj][n] = *(const f32x4*)(bg + col0 + bj * HALF + 4 * n);
#pragma unroll
            for (int m = 0; m < 4; ++m) { const int row = row0 + ai * HALF + m * 16; const size_t off = (size_t)row * 1024 + col0; const float r = rs[m];
#pragma unroll
                for (int bj = 0; bj < 2; ++bj) { const u32x4 hw = hb[m][bj], pw = pb[m][bj];
                    const f32x4 h0 = (f32x4){bf_lo(hw.x), bf_hi(hw.x), bf_lo(hw.y), bf_hi(hw.y)}, h1 = (f32x4){bf_lo(hw.z), bf_hi(hw.z), bf_lo(hw.w), bf_hi(hw.w)};
                    const f32x4 p0 = (f32x4){bf_lo(pw.x), bf_hi(pw.x), bf_lo(pw.y), bf_hi(pw.y)}, p1 = (f32x4){bf_lo(pw.z), bf_hi(pw.z), bf_lo(pw.w), bf_hi(pw.w)};
                    const f32x4 a0 = acc[ai][bj][m][0] * r + bv[bj][0], a1 = acc[ai][bj][m][1] * r + bv[bj][1];
                    f32x4 d0 = a0 * (-1.4426950408889634f), d1 = a1 * (-1.4426950408889634f);
#pragma unroll
                    for (int i2 = 0; i2 < 4; ++i2) { d0[i2] = __builtin_amdgcn_exp2f(d0[i2]); d1[i2] = __builtin_amdgcn_exp2f(d1[i2]); }
                    d0 = d0 + 1.0f; d1 = d1 + 1.0f;
#pragma unroll
                    for (int i2 = 0; i2 < 4; ++i2) { d0[i2] = __builtin_amdgcn_rcpf(d0[i2]); d1[i2] = __builtin_amdgcn_rcpf(d1[i2]); }
                    *(u32x4*)(OUT + off + bj * HALF) = pack8(h0 + d0 * p0, h1 + d1 * p1); } }
            asm volatile("" ::: "memory"); }
    }
};

template <class Epi, class Sched, bool ALIGN_EPI = false, bool SP2 = false>
__device__ __forceinline__ void gemm_phase(PG8_LAS unsigned char* lds, const Gemm g, const Sched& S, const Epi& E, const int wave) {
    int tid_ = wave * 64 + fresh_lane(); asm volatile("" : "+v"(tid_));
    const int tid = tid_, wid = __builtin_amdgcn_readfirstlane(tid >> 6), lane = tid & 63, wr = wid >> 2, wc = wid & 3, fr = lane & 15, fq = lane >> 4;
    const int K = g.K, nt = K / BK;
    unsigned voffA[2], voffB[2];
#pragma unroll
    for (int i = 0; i < 2; ++i) { int R, C; stage_rc(tid * 16 + i * 8192, R, C); const int Rb = Epi::BSPLIT ? (64 * (R >> 5) + perm32(R & 31)) : (Epi::PERM ? ((R & ~31) + perm32(R & 31)) : R);
        voffA[i] = (unsigned)(R * K + C) * 2u; voffB[i] = (unsigned)(Rb * K + C) * 2u; }
    const size_t kstep = (size_t)(BK * 2);
    const size_t hstep = (size_t)HALF * K * 2;
    const size_t tstep = 2 * hstep;
    const size_t hstepB = Epi::BSPLIT ? (size_t)32 * K * 2 : hstep;
    const unsigned ldsw = (unsigned)wid * 1024u;
    const int aoff = lds_byte(wr * 64 + fr, fq * 8), boff = lds_byte(wc * 32 + fr, fq * 8);
#define PG8_SA(b, h) (((b) * 2 + (h)) * HTB)
#define PG8_SB(b, h) ((4 + (b) * 2 + (h)) * HTB)
#define PG8_STAGE(bufoff, gbase, voff) do { _Pragma("unroll") for (int _i = 0; _i < 2; ++_i) \
        __builtin_amdgcn_global_load_lds((const unsigned*)((const char*)(gbase) + (voff)[_i]), (PG8_LAS unsigned*)(lds + (bufoff) + ldsw + _i * 8192), 16, 0, 0); } while (0)
#define PG8_LDA(dst, b, h) do { _Pragma("unroll") for (int m = 0; m < 4; ++m) _Pragma("unroll") for (int k = 0; k < 2; ++k) dst[m][k] = *(const PG8_LAS bf16x8*)(lds + PG8_SA(b, h) + aoff + m * 2048 + k * 1024); } while (0)
#define PG8_LDB(dst, b, h) do { _Pragma("unroll") for (int n = 0; n < 2; ++n) _Pragma("unroll") for (int k = 0; k < 2; ++k) dst[n][k] = *(const PG8_LAS bf16x8*)(lds + PG8_SB(b, h) + boff + n * 2048 + k * 1024); } while (0)
#define PG8_MMA(ai, bj, At, Bt) do { __builtin_amdgcn_s_setprio(1); _Pragma("unroll") for (int m = 0; m < 4; ++m) _Pragma("unroll") for (int n = 0; n < 2; ++n) _Pragma("unroll") for (int k = 0; k < 2; ++k) \
        acc[ai][bj][m][n] = __builtin_amdgcn_mfma_f32_16x16x32_bf16(Bt[n][k], At[m][k], acc[ai][bj][m][n], 0, 0, 0); __builtin_amdgcn_s_setprio(0); } while (0)
#define PG8_WAIT_V(n) asm volatile("s_waitcnt vmcnt(" #n ")" ::: "memory")
#define PG8_WAIT_L(n) asm volatile("s_waitcnt lgkmcnt(" #n ")" ::: "memory")
#define PG8_BAR __builtin_amdgcn_s_barrier()
#define PG8_SCHED __builtin_amdgcn_sched_barrier(0)
    Unit cur, nxt; int ui = 0;
    if (!S.next(0, cur)) return;
    f32x4 acc[2][2][4][2];
#pragma unroll
    for (int a = 0; a < 2; ++a)
#pragma unroll
        for (int b = 0; b < 2; ++b)
#pragma unroll
            for (int m = 0; m < 4; ++m)
#pragma unroll
                for (int n = 0; n < 2; ++n) acc[a][b][m][n] = (f32x4){0.f, 0.f, 0.f, 0.f};
    if constexpr (Epi::RESID_INIT) { typename Epi::Raw R0; E.load_base(R0, cur, wr, wc, fr, fq); E.init_acc(acc, R0); }
    bf16x8 At[4][2], B0[2][2], B1[2][2];
    const char* cA = (const char*)g.A + (size_t)cur.pm * tstep; const char* cB = (const char*)g.Bt + (size_t)cur.pn * tstep;
    S.a_ready(cur);
    if constexpr (SP2) {
        PG8_STAGE(PG8_SB(0, 0), cB, voffB); PG8_STAGE(PG8_SB(0, 1), cB + hstepB, voffB); PG8_STAGE(PG8_SA(0, 0), cA, voffA); PG8_STAGE(PG8_SA(0, 1), cA + hstep, voffA);
        if (wr == 1) PG8_BAR;
        PG8_WAIT_V(2); PG8_BAR;
        PG8_STAGE(PG8_SB(1, 0), cB + kstep, voffB); PG8_STAGE(PG8_SA(1, 0), cA + kstep, voffA); PG8_STAGE(PG8_SB(1, 1), cB + hstepB + kstep, voffB);
        PG8_WAIT_V(6); PG8_BAR;
    } else {
        PG8_STAGE(PG8_SB(0, 0), cB, voffB); PG8_STAGE(PG8_SA(0, 0), cA, voffA); PG8_STAGE(PG8_SB(0, 1), cB + hstepB, voffB); PG8_STAGE(PG8_SA(0, 1), cA + hstep, voffA);
        if (wr == 1) PG8_BAR;
        PG8_WAIT_V(4); PG8_BAR;
        PG8_STAGE(PG8_SB(1, 0), cB + kstep, voffB); PG8_STAGE(PG8_SA(1, 0), cA + kstep, voffA); PG8_STAGE(PG8_SB(1, 1), cB + hstepB + kstep, voffB);
        PG8_WAIT_V(6); PG8_BAR;
    }
    for (;;) {
        const bool has_next = S.next(ui + 1, nxt);
        const char* nA = has_next ? (const char*)g.A + (size_t)nxt.pm * tstep : cA; const char* nB = has_next ? (const char*)g.Bt + (size_t)nxt.pn * tstep : cB;
        for (int t = 0; t < nt; t += 2) {
            const bool last = (t == nt - 2);
            const char* a1 = cA + (size_t)(t + 1) * kstep;
            const char* a2 = last ? nA : cA + (size_t)(t + 2) * kstep; const char* b2 = last ? nB : cB + (size_t)(t + 2) * kstep;
            const char* a3 = a2 + kstep; const char* b3 = b2 + kstep;
            if (last && has_next) S.a_ready(nxt);
            if constexpr (SP2) {
            PG8_LDB(B0, 0, 0); PG8_LDB(B1, 0, 1); PG8_SCHED; PG8_LDA(At, 0, 0); PG8_STAGE(PG8_SA(1, 1), a1 + hstep, voffA);
            PG8_WAIT_V(8); PG8_WAIT_L(0); PG8_BAR; PG8_MMA(0, 0, At, B0); PG8_MMA(0, 1, At, B1); PG8_BAR; PG8_SCHED;
            PG8_LDA(At, 0, 1); PG8_STAGE(PG8_SB(0, 0), b2, voffB); PG8_STAGE(PG8_SB(0, 1), b2 + hstepB, voffB); PG8_STAGE(PG8_SA(0, 0), a2, voffA);
            PG8_WAIT_V(8); PG8_WAIT_L(0); PG8_BAR; PG8_MMA(1, 0, At, B0); PG8_MMA(1, 1, At, B1); PG8_BAR; PG8_SCHED;
            PG8_LDB(B0, 1, 0); PG8_LDB(B1, 1, 1); PG8_SCHED; PG8_LDA(At, 1, 0); PG8_STAGE(PG8_SA(0, 1), a2 + hstep, voffA);
            PG8_WAIT_V(8); PG8_WAIT_L(0); PG8_BAR; PG8_MMA(0, 0, At, B0); PG8_MMA(0, 1, At, B1); PG8_BAR; PG8_SCHED;
            PG8_LDA(At, 1, 1); PG8_STAGE(PG8_SB(1, 0), b3, voffB); PG8_STAGE(PG8_SB(1, 1), b3 + hstepB, voffB); PG8_STAGE(PG8_SA(1, 0), a3, voffA);
            PG8_WAIT_V(8); PG8_WAIT_L(0); PG8_BAR; PG8_MMA(1, 0, At, B0); PG8_MMA(1, 1, At, B1); PG8_BAR; PG8_SCHED;
            } else {
            PG8_LDB(B0, 0, 0); PG8_SCHED; PG8_LDA(At, 0, 0); PG8_STAGE(PG8_SA(1, 1), a1 + hstep, voffA);
            PG8_WAIT_L(8); PG8_BAR; PG8_WAIT_L(0); PG8_MMA(0, 0, At, B0); PG8_BAR; PG8_SCHED;
            PG8_LDB(B1, 0, 1); PG8_STAGE(PG8_SB(0, 0), b2, voffB);
            PG8_BAR; PG8_WAIT_L(0); PG8_MMA(0, 1, At, B1); PG8_BAR;
            PG8_LDA(At, 0, 1); PG8_STAGE(PG8_SA(0, 0), a2, voffA);
            PG8_BAR; PG8_WAIT_L(0); PG8_MMA(1, 0, At, B0); PG8_BAR; PG8_SCHED;
            PG8_STAGE(PG8_SB(0, 1), b2 + hstepB, voffB);
            PG8_WAIT_V(6); PG8_BAR; PG8_MMA(1, 1, At, B1); PG8_BAR;
            PG8_LDB(B0, 1, 0); PG8_SCHED; PG8_LDA(At, 1, 0); PG8_STAGE(PG8_SA(0, 1), a2 + hstep, voffA);
            PG8_WAIT_L(8); PG8_BAR; PG8_WAIT_L(0); PG8_MMA(0, 0, At, B0); PG8_BAR; PG8_SCHED;
            PG8_LDB(B1, 1, 1); PG8_STAGE(PG8_SB(1, 0), b3, voffB);
            PG8_BAR; PG8_WAIT_L(0); PG8_MMA(0, 1, At, B1); PG8_BAR;
            PG8_LDA(At, 1, 1); PG8_STAGE(PG8_SA(1, 0), a3, voffA);
            PG8_BAR; PG8_WAIT_L(0); PG8_MMA(1, 0, At, B0); PG8_BAR; PG8_SCHED;
            PG8_STAGE(PG8_SB(1, 1), b3 + hstepB, voffB);
            PG8_WAIT_V(6); PG8_BAR; PG8_MMA(1, 1, At, B1); PG8_BAR;
            }
        }
        if constexpr (ALIGN_EPI) { if (wr == 0) PG8_BAR; }
        if constexpr (Epi::RESID_INIT) {
            typename Epi::Raw Rn; { Unit ln = cur; if (has_next) ln = nxt; E.load_base(Rn, ln, wr, wc, fr, fq); }
            E(acc, cur, wr, wc, fr, fq); S.done(cur);
            if (!has_next) break;
            E.init_acc(acc, Rn);
        } else {
        if constexpr (!Epi::AFTER_DRAIN) { E(acc, cur, wr, wc, fr, fq); S.done(cur); }
        if (!has_next) break;
#pragma unroll
        for (int a = 0; a < 2; ++a)
#pragma unroll
            for (int b = 0; b < 2; ++b)
#pragma unroll
                for (int m = 0; m < 4; ++m)
#pragma unroll
                    for (int n = 0; n < 2; ++n) acc[a][b][m][n] = (f32x4){0.f, 0.f, 0.f, 0.f};
        }
        cur = nxt; cA = nA; cB = nB; ++ui;
        if constexpr (ALIGN_EPI) { if (wr == 1) PG8_BAR; }
    }
    PG8_WAIT_V(0);
    if constexpr (!ALIGN_EPI) { if (wr == 0) PG8_BAR; }
    PG8_BAR;
    if constexpr (Epi::AFTER_DRAIN) { E.fused(acc, cur, wr, wc, fr, fq, lds, wid, lane); S.done(cur); }
#undef PG8_SA
#undef PG8_SB
#undef PG8_STAGE
#undef PG8_LDA
#undef PG8_LDB
#undef PG8_MMA
#undef PG8_WAIT_V
#undef PG8_WAIT_L
#undef PG8_BAR
#undef PG8_SCHED
}
}

#ifndef PG8_SP2
#define PG8_SP2 true
#endif
#ifndef PG8_ALIGN
#define PG8_ALIGN true
#endif
namespace attn_body {
using bf16=__hip_bfloat16;
using bf16x8=__attribute__((ext_vector_type(8)))short;
using s16x4=__attribute__((ext_vector_type(4)))short;
using f32x16=__attribute__((ext_vector_type(16)))float;
using f32x4a=__attribute__((ext_vector_type(4)))float;
using u32x4=__attribute__((ext_vector_type(4)))unsigned;
constexpr int NHEAD=8,SEQL=4096,D=64,DMI=3072,DMO=1024;
constexpr int NW=8,QBLK=32,QB=QBLK*NW,KVBLK=64,NQB=SEQL/QB;
__device__ __forceinline__ int crow(int r,int hi){return (r&3)+8*(r>>2)+4*hi;}
#define SBAR() __builtin_amdgcn_sched_barrier(0)
__device__ __forceinline__ void cmask(f32x16&p0,f32x16&p1,int jb,int qrel,int hi){
  const float NEG=-INFINITY; int kb=64*jb+4*hi; asm volatile("":"+v"(kb));
  #pragma unroll
  for(int r=0;r<16;++r){int kv=kb+(r&3)+8*(r>>2); if(kv>qrel)p0[r]=NEG; if(kv+32>qrel)p1[r]=NEG;}
}

constexpr int NSLOT=3, SLOTB=8192;
constexpr int LDS_K=0, LDS_V=NSLOT*SLOTB, LDS_WS=2*NSLOT*SLOTB, LDS_OST=LDS_WS+NW*64*4, LDS_CLT=LDS_OST+NW*4096, LDS_BYTES=LDS_CLT+SEQL*4;
__device__ __forceinline__ void glds16(const void*gsrc,unsigned lds_dst){unsigned keep;
  asm volatile("s_mov_b32 %0, m0\n\ts_mov_b32 m0, %2\n\ts_nop 0\n\tglobal_load_lds_dwordx4 %1, off\n\ts_mov_b32 m0, %0":"=&s"(keep):"v"(gsrc),"s"(lds_dst):"memory");}
__device__ __forceinline__ float max3f(float a,float b,float c){float r;asm("v_max3_f32 %0, %1, %2, %3":"=v"(r):"v"(a),"v"(b),"v"(c));return r;}
__device__ __forceinline__ float max2f(float a,float b){float r;asm("v_max_f32_e32 %0, %1, %2":"=v"(r):"v"(a),"v"(b));return r;}
typedef float f32x2_t __attribute__((ext_vector_type(2))); typedef __bf16 bf16x2_t __attribute__((ext_vector_type(2)));
__device__ __forceinline__ unsigned cvtpk_s(float lo,float hi){f32x2_t v={lo,hi};bf16x2_t b=__builtin_convertvector(v,bf16x2_t);return __builtin_bit_cast(unsigned,b);}
#define WAIT_BAR(N) asm volatile("s_waitcnt vmcnt(" #N ") lgkmcnt(0)\n\ts_barrier":::"memory")
template<int MASK> __device__ __forceinline__ float xor_lane(float v){
  if constexpr(MASK==32){ auto rr=__builtin_amdgcn_permlane32_swap(__float_as_uint(v),__float_as_uint(v),false,false); return __uint_as_float((pg8::fresh_lane()&32)?rr[0]:rr[1]); }
  else return __int_as_float(__builtin_amdgcn_ds_swizzle(__float_as_int(v),(MASK<<10)|0x1f)); }

__device__ __forceinline__ void qkt(f32x16&p0,f32x16&p1,const char*Kslot,const bf16x8*qr,int r32,int hi){
  const char*kb=Kslot+hi*1024+r32*16;
  #pragma unroll
  for(int d0=0;d0<4;++d0){
    const bf16x8 b0=*reinterpret_cast<const bf16x8*>(kb+d0*2048);
    const bf16x8 b1=*reinterpret_cast<const bf16x8*>(kb+d0*2048+512);
    p0=__builtin_amdgcn_mfma_f32_32x32x16_bf16(b0,qr[d0],p0,0,0,0);p1=__builtin_amdgcn_mfma_f32_32x32x16_bf16(b1,qr[d0],p1,0,0,0);}
}
typedef __attribute__((address_space(3))) const char* lds_cptr;
typedef short v4i16_t __attribute__((ext_vector_type(4)));
__device__ __forceinline__ void kload8(bf16x8*kf,lds_cptr kp){
  kf[0]=*(const __attribute__((address_space(3))) bf16x8*)(kp);      kf[1]=*(const __attribute__((address_space(3))) bf16x8*)(kp+512);
  kf[2]=*(const __attribute__((address_space(3))) bf16x8*)(kp+2048); kf[3]=*(const __attribute__((address_space(3))) bf16x8*)(kp+2560);
  kf[4]=*(const __attribute__((address_space(3))) bf16x8*)(kp+4096); kf[5]=*(const __attribute__((address_space(3))) bf16x8*)(kp+4608);
  kf[6]=*(const __attribute__((address_space(3))) bf16x8*)(kp+6144); kf[7]=*(const __attribute__((address_space(3))) bf16x8*)(kp+6656);
}
__device__ __forceinline__ void kload2(bf16x8*kf,lds_cptr kp,int j){ kf[2*j]=*(const __attribute__((address_space(3))) bf16x8*)(kp+j*2048); kf[2*j+1]=*(const __attribute__((address_space(3))) bf16x8*)(kp+j*2048+512); }
__device__ __forceinline__ s16x4 vtr(lds_cptr p){ return __builtin_bit_cast(s16x4,__builtin_amdgcn_ds_read_tr16_b64_v4i16((__attribute__((address_space(3))) v4i16_t*)p)); }
__device__ __forceinline__ float rowmax(const f32x16&p0,const f32x16&p1){
  float a=max3f(p0[0],p0[1],p1[0]),b=max3f(p0[2],p0[3],p1[1]);a=max3f(a,p1[2],p1[3]);
  #pragma unroll
  for(int r=4;r<16;r+=4){a=max3f(a,p0[r],p0[r+1]);b=max3f(b,p0[r+2],p0[r+3]);a=max3f(a,p1[r],p1[r+1]);b=max3f(b,p1[r+2],p1[r+3]);}
  const float m=max2f(a,b);
  auto rr=__builtin_amdgcn_permlane32_swap(__float_as_uint(m),__float_as_uint(m),false,false);
  return max2f(__uint_as_float(rr[0]),__uint_as_float(rr[1]));
}
__device__ __forceinline__ void pv(f32x16*o,int vb,bf16x8 pa0,bf16x8 pa1,bf16x8 pa2,bf16x8 pa3){
  #pragma unroll
  for(int d0=0;d0<2;++d0){s16x4 lo[4],hi[4];
    #pragma unroll
    for(int ks=0;ks<4;++ks){
      asm volatile("ds_read_b64_tr_b16 %0,%1 offset:%c2":"=&v"(lo[ks]):"v"(vb),"i"(d0*4096+ks*1024):"memory");
      asm volatile("ds_read_b64_tr_b16 %0,%1 offset:%c2":"=&v"(hi[ks]):"v"(vb),"i"(d0*4096+ks*1024+512):"memory");}
    asm volatile("s_waitcnt lgkmcnt(0)":::"memory");SBAR();
    #define PK(k) (bf16x8){lo[k][0],lo[k][1],lo[k][2],lo[k][3],hi[k][0],hi[k][1],hi[k][2],hi[k][3]}
    o[d0]=__builtin_amdgcn_mfma_f32_32x32x16_bf16(pa0,PK(0),o[d0],0,0,0);
    o[d0]=__builtin_amdgcn_mfma_f32_32x32x16_bf16(pa1,PK(1),o[d0],0,0,0);
    o[d0]=__builtin_amdgcn_mfma_f32_32x32x16_bf16(pa2,PK(2),o[d0],0,0,0);
    o[d0]=__builtin_amdgcn_mfma_f32_32x32x16_bf16(pa3,PK(3),o[d0],0,0,0);
    #undef PK
  }
}

__device__ __forceinline__ int attn_skip_t0(int qb,const float*CLrow,const float*KNrow,const float*QNp,int lane){
  const int q0=qb*QB,NT0=(q0+QB)/KVBLK; const float ql=sqrtf(QNp[0])*1.004f,qh=sqrtf(QNp[1])*1.004f; float bnd=0.f,clend=0.f;
  if(lane<NT0){ bnd=ql*sqrtf(KNrow[2*lane])*1.004f+qh*sqrtf(KNrow[2*lane+1])*1.004f; clend=CLrow[64*lane+63]; }
  const float clq0=CLrow[q0]; float bd=(lane>=NT0-4&&lane<NT0)?bnd:0.f;
  bd=__builtin_fmaxf(bd,xor_lane<1>(bd)); bd=__builtin_fmaxf(bd,xor_lane<2>(bd)); bd=__builtin_fmaxf(bd,xor_lane<4>(bd)); bd=__builtin_fmaxf(bd,xor_lane<8>(bd)); bd=__builtin_fmaxf(bd,xor_lane<16>(bd));
  { auto rr=__builtin_amdgcn_permlane32_swap(__float_as_uint(bd),__float_as_uint(bd),false,false); bd=__builtin_fmaxf(__uint_as_float(rr[0]),__uint_as_float(rr[1])); }
  const bool skip=(lane<NT0-4)&&(bnd+(clq0-clend)<-bd-32.0f);
  const unsigned long long inv=~__ballot(skip); const int run=inv?__builtin_ctzll(inv):64;
  return __builtin_amdgcn_readfirstlane(((run<NT0-4)?run:(NT0-4))&~1);
}
#ifndef ATTN_STORE16
#define ATTN_STORE16(p,v) (*(u32x4*)(p)=(v))
#endif
template<int THRL> __device__ __forceinline__ void attn_unit(int b,int h,int qb,const bf16*Q,const bf16*__restrict__ K,const bf16*__restrict__ V,bf16*O,const float*CLrow,const float*gout,const int t0,char*shm,const int wave){
  int tid_=wave*64+pg8::fresh_lane(); asm volatile("":"+v"(tid_));
  const int tid=tid_,lane=tid&63,r32=lane&31,hi=lane>>5; const int wid=__builtin_amdgcn_readfirstlane(tid>>6);
  const long rowbase=(long)b*SEQL; const int q0=qb*QB;
  const bf16*Qw=Q+(rowbase+q0+wid*QBLK)*DMI+h*D;
  const bf16*Kh=K+rowbase*DMI+h*D,*Vh=V+rowbase*DMI+h*D;
  const unsigned lds0=(unsigned)(uintptr_t)shm;
  float*wsf=(float*)(shm+LDS_WS)+wid*64;
  const lds_cptr shm3=(lds_cptr)shm;
  { const float*csrc=CLrow+wid*256+lane*4; const unsigned cdst=lds0+LDS_CLT+wid*1024;
    glds16(csrc,(unsigned)__builtin_amdgcn_readfirstlane(cdst)); glds16(csrc+2048,(unsigned)__builtin_amdgcn_readfirstlane(cdst+8192)); }
  const bf16*ksrc=Kh+(long)t0*KVBLK*DMI+(long)lane*DMI+wid*8;
  const bf16*vsrc=Vh+(long)t0*KVBLK*DMI+(long)(16*(wid&3)+(lane>>2))*DMI+(wid>>2)*32+(lane&3)*8;
  const unsigned kdst=lds0+LDS_K+wid*1024, vdst=lds0+LDS_V+wid*1024;
  #define DMA_K(t,slot) glds16(ksrc+(long)(t)*KVBLK*DMI,(unsigned)__builtin_amdgcn_readfirstlane(kdst+(slot)))
  #define DMA_V(t,slot) glds16(vsrc+(long)(t)*KVBLK*DMI,(unsigned)__builtin_amdgcn_readfirstlane(vdst+(slot)))
  const int vb0=(int)(lds0+LDS_V)+((lane>>4)&1)*32+(lane&3)*8+(4*hi+((lane&15)>>2))*64;
  const char*Kbase=shm+LDS_K; bf16x8 kf[8];
  const lds_cptr kp0=shm3+LDS_K+hi*1024+r32*16; const lds_cptr vp0=shm3+LDS_V+((lane>>4)&1)*32+(lane&3)*8+(4*hi+((lane&15)>>2))*64;
  const lds_cptr clp0=shm3+LDS_CLT+hi*16+t0*256;
  const int NT=(q0+QB)/KVBLK-t0;
  DMA_K(0,0);DMA_V(0,0);DMA_K(1,SLOTB);
  bf16x8 qr[4];
  #pragma unroll
  for(int d0=0;d0<4;++d0)qr[d0]=*reinterpret_cast<const bf16x8*>(&Qw[(long)r32*DMI+d0*16+hi*8]);
  float mhat=0.f,l_reg=0.f;f32x16 o[2];o[0]=f32x16{};o[1]=f32x16{};
  const int qrel=wid*QBLK+r32;
  #define CMASK(P0,P1,t) do{int jb_=(t)-(NT-4); if(jb_>=0)cmask(P0,P1,jb_,qrel,hi);}while(0)
  #define CQ(C,g_,off_) do{ const f32x4a a_=*(const __attribute__((address_space(3))) f32x4a*)(cp_+32*(g_)+(off_)); \
      C[4*(g_)]=base_-a_[0]; C[4*(g_)+1]=base_-a_[1]; C[4*(g_)+2]=base_-a_[2]; C[4*(g_)+3]=base_-a_[3]; }while(0)
  #define CINIT(C0,C1,t) do{ const lds_cptr cp_=clp0+(t)*256; const float base_=cql-mhat; \
    CQ(C0,0,0); CQ(C0,1,0); SBAR(); CQ(C0,2,0); CQ(C0,3,0); SBAR(); CQ(C1,0,128); CQ(C1,1,128); SBAR(); CQ(C1,2,128); CQ(C1,3,128); }while(0)
  bool resc=false;
  #define RESC() do{ if(resc){ asm volatile("s_waitcnt lgkmcnt(0)":::"memory"); \
      _Pragma("unroll") for(int d_=0;d_<2;++d_) _Pragma("unroll") for(int r=0;r<16;++r)o[d_][r]*=wsf[crow(r,hi)]; } }while(0)
  f32x16 pA0,pA1,pB0,pB1;
  int sl_prev=0,sl_cur=0,sl_next=SLOTB;
  #define ROT() do{sl_prev=sl_cur;sl_cur=sl_next;sl_next=(sl_next==(NSLOT-1)*SLOTB)?0:sl_next+SLOTB;}while(0)
  DMA_K(2,2*SLOTB);
  WAIT_BAR(3);
  const float cql=*(const __attribute__((address_space(3))) float*)(shm3+LDS_CLT+(q0+qrel)*4);
  CINIT(pA0,pA1,0);
  qkt(pA0,pA1,Kbase,qr,r32,hi);CMASK(pA0,pA1,0);
  { const float rm=rowmax(pA0,pA1);
    if(__any(rm>(float)THRL)){ const float dl=__builtin_fmaxf(rm,0.f); mhat+=dl;
      _Pragma("unroll") for(int r=0;r<16;++r){pA0[r]-=dl;pA1[r]-=dl;} }
    _Pragma("unroll") for(int r=0;r<16;++r){pA0[r]=__builtin_amdgcn_exp2f(pA0[r]);pA1[r]=__builtin_amdgcn_exp2f(pA1[r]);} }
  WAIT_BAR(0);
  DMA_K(3,0);DMA_V(1,SLOTB);
  ROT();
  kload8(kf,kp0+sl_cur);
  CINIT(pB0,pB1,1);
  WAIT_BAR(2);
  s16x4 vlo[4],vhi[4]; u32x4 pw0,pw1,pw2,pw3;
  #define PKW(P,B) cvtpk_s(P[B],P[B+1])
  #define PAF(k) __builtin_bit_cast(bf16x8,pw##k)
  #define VFR(i) (bf16x8){vlo[i][0],vlo[i][1],vlo[i][2],vlo[i][3],vhi[i][0],vhi[i][1],vhi[i][2],vhi[i][3]}
  #define PIN(x) asm volatile("":"+v"(x))
  #define MX3(a,b,c) __builtin_fmaxf(__builtin_fmaxf((a),(b)),(c))
  #define GAPA(MF,A0,A1,A2,A3,W0,W1,PW) do{ MF; sacc+=A0; sacc+=A1; sacc+=A2; sacc+=A3; PIN(sacc); W0; W1; PIN(PW); SBAR(); }while(0)
  #define EX(v) __builtin_amdgcn_exp2f(v)
  #define GAPB(MF,X,B) do{ MF; X[B]=EX(X[B]); X[B+1]=EX(X[B+1]); X[B+2]=EX(X[B+2]); X[B+3]=EX(X[B+3]); PIN(X); SBAR(); }while(0)
  #define VRD(s_,i) do{ vlo[s_]=vtr(vp_+(((i)>>2)*4096+((i)&3)*1024)); vhi[s_]=vtr(vp_+(((i)>>2)*4096+((i)&3)*1024+512)); }while(0)
  #define KRD(G,j) do{ if(G){ kload2(kf,kp0+sl_next,j); SBAR(); } }while(0)
  #define CLD(dst,k) do{ dst=*(const __attribute__((address_space(3))) f32x4a*)(cpn_+32*((k)&3)+128*((k)>>2)); }while(0)
  #define CSUB(P,g,a) do{ P[4*(g)]=basen_-a[0]; P[4*(g)+1]=basen_-a[1]; P[4*(g)+2]=basen_-a[2]; P[4*(g)+3]=basen_-a[3]; }while(0)
  #define STEP(C0,C1,P0,P1,t,GK,GV,GL) do{ SBAR(); \
    const lds_cptr vp_=vp0+sl_prev; \
    float sacc=(P0[0]+P0[1]); \
    GAPA(C0=__builtin_amdgcn_mfma_f32_32x32x16_bf16(kf[0],qr[0],C0,0,0,0), P0[2],P0[3],P0[4],P0[5],     pw0[0]=PKW(P0,0), pw0[1]=PKW(P0,2), pw0); \
    GAPA(C1=__builtin_amdgcn_mfma_f32_32x32x16_bf16(kf[1],qr[0],C1,0,0,0), P0[6],P0[7],P0[8],P0[9],     pw0[2]=PKW(P0,4), pw0[3]=PKW(P0,6), pw0); \
    GAPA(C0=__builtin_amdgcn_mfma_f32_32x32x16_bf16(kf[2],qr[1],C0,0,0,0),   P0[10],P0[11],P0[12],P0[13], pw1[0]=PKW(P0,8), pw1[1]=PKW(P0,10), pw1); \
    GAPA(C1=__builtin_amdgcn_mfma_f32_32x32x16_bf16(kf[3],qr[1],C1,0,0,0),   P0[14],P0[15],P1[0],P1[1],   pw1[2]=PKW(P0,12),pw1[3]=PKW(P0,14), pw1); \
    VRD(0,0); SBAR(); GAPA(C0=__builtin_amdgcn_mfma_f32_32x32x16_bf16(kf[4],qr[2],C0,0,0,0),   P1[2],P1[3],P1[4],P1[5],     pw2[0]=PKW(P1,0), pw2[1]=PKW(P1,2), pw2); \
    VRD(1,4); SBAR(); GAPA(C1=__builtin_amdgcn_mfma_f32_32x32x16_bf16(kf[5],qr[2],C1,0,0,0),   P1[6],P1[7],P1[8],P1[9],     pw2[2]=PKW(P1,4), pw2[3]=PKW(P1,6), pw2); \
    VRD(2,1); SBAR(); GAPA(C0=__builtin_amdgcn_mfma_f32_32x32x16_bf16(kf[6],qr[3],C0,0,0,0),   P1[10],P1[11],P1[12],P1[13], pw3[0]=PKW(P1,8), pw3[1]=PKW(P1,10), pw3); \
    VRD(3,5); SBAR(); GAPA(C1=__builtin_amdgcn_mfma_f32_32x32x16_bf16(kf[7],qr[3],C1,0,0,0),   P1[14],P1[15],0.f,0.f,       pw3[2]=PKW(P1,12),pw3[3]=PKW(P1,14), pw3); \
    l_reg+=sacc; \
    if(GK){DMA_K((t)+3,sl_cur);} if(GV){DMA_V((t)+1,sl_next);} \
    CMASK(C0,C1,t); \
    { float a=MX3(C0[0],C0[1],C1[0]),b=MX3(C0[2],C0[3],C1[1]); a=MX3(a,C1[2],C1[3]); \
      _Pragma("unroll") for(int r=4;r<16;r+=4){a=MX3(a,C0[r],C0[r+1]);b=MX3(b,C0[r+2],C0[r+3]);a=MX3(a,C1[r],C1[r+1]);b=MX3(b,C1[r+2],C1[r+3]);} \
      float rm=__builtin_fmaxf(a,b); { auto rr=__builtin_amdgcn_permlane32_swap(__float_as_uint(rm),__float_as_uint(rm),false,false); rm=__builtin_fmaxf(__uint_as_float(rr[0]),__uint_as_float(rr[1])); } \
      resc=false; \
      if(__builtin_expect(__any(rm>(float)THRL),0)){ const float dl=__builtin_fmaxf(rm,0.f); mhat+=dl; \
        _Pragma("unroll") for(int r=0;r<16;++r){C0[r]-=dl;C1[r]-=dl;} \
        const float f=__builtin_amdgcn_exp2f(-dl); l_reg*=f; if(hi==0)wsf[r32]=f; resc=true; } } \
    const lds_cptr cpn_=clp0+((t)+1)*256; const float basen_=cql-mhat; f32x4a ca_; \
    SBAR(); \
    CLD(ca_,0); GAPB(o[0]=__builtin_amdgcn_mfma_f32_32x32x16_bf16(PAF(0),VFR(0),o[0],0,0,0), C0,0); \
    VRD(0,2); CSUB(P0,0,ca_); CLD(ca_,1); GAPB(o[1]=__builtin_amdgcn_mfma_f32_32x32x16_bf16(PAF(0),VFR(1),o[1],0,0,0), C0,4); \
    VRD(1,6); KRD(GL,0); CSUB(P0,1,ca_); CLD(ca_,2); GAPB(o[0]=__builtin_amdgcn_mfma_f32_32x32x16_bf16(PAF(1),VFR(2),o[0],0,0,0), C0,8); \
    VRD(2,3); KRD(GL,1); CSUB(P0,2,ca_); CLD(ca_,3); GAPB(o[1]=__builtin_amdgcn_mfma_f32_32x32x16_bf16(PAF(1),VFR(3),o[1],0,0,0), C0,12); \
    VRD(3,7); KRD(GL,2); CSUB(P0,3,ca_); CLD(ca_,4); GAPB(o[0]=__builtin_amdgcn_mfma_f32_32x32x16_bf16(PAF(2),VFR(0),o[0],0,0,0), C1,0); \
    KRD(GL,3); CSUB(P1,0,ca_); CLD(ca_,5); GAPB(o[1]=__builtin_amdgcn_mfma_f32_32x32x16_bf16(PAF(2),VFR(1),o[1],0,0,0), C1,4); \
    CSUB(P1,1,ca_); CLD(ca_,6); GAPB(o[0]=__builtin_amdgcn_mfma_f32_32x32x16_bf16(PAF(3),VFR(2),o[0],0,0,0), C1,8); \
    CSUB(P1,2,ca_); CLD(ca_,7); GAPB(o[1]=__builtin_amdgcn_mfma_f32_32x32x16_bf16(PAF(3),VFR(3),o[1],0,0,0), C1,12); \
    CSUB(P1,3,ca_); SBAR(); \
    }while(0)
  int t=1;
  #undef CMASK
  #define CMASK(P0,P1,t) do{}while(0)
  for(;t+5<NT;t+=2){
    STEP(pB0,pB1,pA0,pA1,t,true,true,true);     WAIT_BAR(2); RESC(); ROT();
    STEP(pA0,pA1,pB0,pB1,t+1,true,true,true);   WAIT_BAR(2); RESC(); ROT();
  }
  #undef CMASK
  #define CMASK(P0,P1,t) do{int jb_=(t)-(NT-4); if(jb_>=0)cmask(P0,P1,jb_,qrel,hi);}while(0)
  #define ENDW(tt) do{ if((tt)+3<NT){WAIT_BAR(2);} else if((tt)+2<NT){WAIT_BAR(1);} else {WAIT_BAR(0);} }while(0)
  for(;t+1<NT;t+=2){
    STEP(pB0,pB1,pA0,pA1,t,(t+3<NT),(t+1<NT),(t+1<NT));       ENDW(t);   RESC(); ROT();
    STEP(pA0,pA1,pB0,pB1,t+1,(t+4<NT),(t+2<NT),(t+2<NT));     ENDW(t+1); RESC(); ROT();
  }
  STEP(pB0,pB1,pA0,pA1,NT-1,false,false,false); RESC();
  { float sacc=pB0[0]+pB0[1]; _Pragma("unroll") for(int r=2;r<16;++r)sacc+=pB0[r]; _Pragma("unroll") for(int r=0;r<16;++r)sacc+=pB1[r]; l_reg+=sacc;
    pw0=(u32x4){PKW(pB0,0),PKW(pB0,2),PKW(pB0,4),PKW(pB0,6)};pw1=(u32x4){PKW(pB0,8),PKW(pB0,10),PKW(pB0,12),PKW(pB0,14)};pw2=(u32x4){PKW(pB1,0),PKW(pB1,2),PKW(pB1,4),PKW(pB1,6)};pw3=(u32x4){PKW(pB1,8),PKW(pB1,10),PKW(pB1,12),PKW(pB1,14)};
    SBAR(); pv(o,vb0+sl_cur,PAF(0),PAF(1),PAF(2),PAF(3)); }
  #undef PKW
  #undef PAF
  #undef VFR
  #undef PIN
  #undef MX3
  #undef GAPA
  #undef GAPB
  #undef EX
  #undef VRD
  #undef KRD
  #undef STEP
  #undef ENDW
  #undef CINIT
  #undef CQ
  #undef CLD
  #undef CSUB
  {auto rr=__builtin_amdgcn_permlane32_swap(__float_as_uint(l_reg),__float_as_uint(l_reg),false,false);l_reg=__uint_as_float(rr[0])+__uint_as_float(rr[1]);}
  if(hi==0)wsf[32+r32]=l_reg;asm volatile("s_waitcnt lgkmcnt(0)":::"memory");
  const float g0=gout[r32],g1=gout[32+r32];
  #pragma unroll
  for(int r=0;r<16;++r){ const float rl=__builtin_amdgcn_rcpf(wsf[32+crow(r,hi)]); const float y0=o[0][r]*rl,y1=o[1][r]*rl; float s=y0*y0+y1*y1;
    s+=xor_lane<1>(s); s+=xor_lane<2>(s); s+=xor_lane<4>(s); s+=xor_lane<8>(s); s+=xor_lane<16>(s);
    const float rs=__builtin_amdgcn_rsqf(s*(1.0f/64.0f)+1e-6f); o[0][r]=y0*rs*g0; o[1][r]=y1*rs*g1; }
  bf16*Ow=O+(rowbase+q0+wid*QBLK)*DMO+h*D;
  { bf16*stg=(bf16*)(shm+LDS_OST)+wid*2048;
    #pragma unroll
    for(int r=0;r<16;++r){const int orow=crow(r,hi);
      #pragma unroll
      for(int d0=0;d0<2;++d0)stg[orow*64+d0*32+r32]=__float2bfloat16(o[d0][r]);}
    asm volatile("s_waitcnt lgkmcnt(0)":::"memory");
    #pragma unroll
    for(int i=0;i<4;++i){const int row=i*8+(lane>>3),ch=lane&7; const u32x4 v=*(const u32x4*)(stg+row*64+ch*8); ATTN_STORE16(Ow+(long)row*DMO+ch*8,v);} }
  asm volatile("s_waitcnt lgkmcnt(0)\n\ts_barrier":::"memory");
  #undef DMA_K
  #undef DMA_V
  #undef CMASK
  #undef RESC
  #undef ROT
}
constexpr int ATTN_LDS_BYTES=LDS_BYTES;
struct AttnTensors { const bf16* Q; const bf16* K; const bf16* V; bf16* O; const float* CL; const float* gout; };
#undef SBAR
#undef WAIT_BAR
}

constexpr size_t MiB = 1u << 20;
constexpr size_t WS_CTL = 0, CTL_ZERO_BYTES = 1 * MiB;
constexpr size_t WS_WIN = 2 * MiB;
constexpr size_t WS_WO  = 8 * MiB;
constexpr size_t WS_WGU = 10 * MiB;
constexpr size_t WS_WD  = 21 * MiB;
constexpr size_t WS_WPG = 27 * MiB;
constexpr size_t WS_WPP = 29 * MiB;
constexpr size_t WS_LF  = 30 * MiB;
constexpr size_t WS_CL  = 32 * MiB;
constexpr size_t WS_SSQ1 = 34 * MiB;
constexpr size_t WS_SSQ2 = 38 * MiB;
constexpr size_t WS_IRX = 42 * MiB;
constexpr size_t WS_PB  = 48 * MiB;
constexpr size_t WS_XN  = 96 * MiB;
constexpr size_t WS_Z   = 224 * MiB;
constexpr size_t WS_Y   = 608 * MiB;
constexpr size_t WS_PROJ = 736 * MiB;
constexpr size_t WS_CUB = 864 * MiB;
constexpr size_t WS_END = 928 * MiB;
constexpr int CW_BAR = 4096;
constexpr size_t CTL_KN = 65536, CTL_QN = 131072, CTL_CONVQ = 196608;

constexpr int RING_OFF = 0, RING_BYTES = 131072;
constexpr int LDSCTL_OFF = RING_BYTES, MISC_OFF = LDSCTL_OFF + 320;
constexpr int SPARE_OFF = RING_BYTES + 1024;
constexpr int LDS_BYTES = 147456;
static_assert(MISC_OFF + 128 <= LDS_BYTES, "LDS map");
constexpr int NWAVES = 8;

#define GAS __attribute__((address_space(1)))
#define LAS __attribute__((address_space(3)))
typedef unsigned short bf16;
typedef unsigned v4u __attribute__((ext_vector_type(4)));
typedef float f32x4 __attribute__((ext_vector_type(4)));
typedef short bf16x8 __attribute__((ext_vector_type(8)));
typedef GAS unsigned gu32;
typedef GAS unsigned long long gu64;
#define RLX_AGENT __ATOMIC_RELAXED, __HIP_MEMORY_SCOPE_AGENT
#define LDS_WAIT() asm volatile("s_waitcnt lgkmcnt(0)" ::: "memory")
#define VM_WAIT() asm volatile("s_waitcnt vmcnt(0)" ::: "memory")
__device__ __forceinline__ unsigned long long rt() { return __builtin_amdgcn_s_memrealtime(); }
__device__ __forceinline__ unsigned f2bf(float f) { unsigned u = __builtin_bit_cast(unsigned, f); return (u + 0x7fffu + ((u >> 16) & 1u)) >> 16; }
__device__ __forceinline__ unsigned pk2(float lo, float hi) { return f2bf(lo) | (f2bf(hi) << 16); }

#define XB_TMO      128
#define XB_XCNT(j)  (256  + 64 * (j))
#define XB_XSUB(j)  (1280 + 64 * (j))
#define XB_XGEN(j)  (2304 + 64 * (j))
#define XB_TOP      3328
#define XB_TOPGEN   3392
#define XCD_BAR_WORDS 3456
#define XB_SPIN_CAP (1u << 18)

__device__ __forceinline__ unsigned xb_ld(unsigned* p)              { return __hip_atomic_load(p, __ATOMIC_RELAXED, __HIP_MEMORY_SCOPE_AGENT); }
__device__ __forceinline__ unsigned xb_add(unsigned* p, unsigned v) { return __hip_atomic_fetch_add(p, v, __ATOMIC_RELAXED, __HIP_MEMORY_SCOPE_AGENT); }
__device__ __forceinline__ unsigned xb_xcc_id() { return (unsigned)__builtin_amdgcn_s_getreg((3 << 11) | 20) & 0xFu; }
#define XB_SPIN(cond, bar) do { unsigned _sp = 0; while (cond) { __builtin_amdgcn_s_sleep(1); \
    if ((++_sp & 255u) == 0u) { if (xb_ld(&(bar)[XB_TMO])) break; if (_sp > XB_SPIN_CAP) { atomicAdd(&(bar)[XB_TMO], 1u); break; } } } } while (0)

struct XcdBarrier {
    int wave;
    unsigned* bar; unsigned x;
    volatile LAS unsigned* st;
};

__device__ __forceinline__ XcdBarrier xcd_barrier_post(unsigned* bar, volatile LAS unsigned* st, int wave) {
    XcdBarrier b; b.wave = wave; b.bar = bar; b.x = xb_xcc_id(); b.st = st;
    if (wave == 0 && pg8::fresh_lane() == 0) (void)xb_add(&bar[XB_XCNT(b.x)], 1u);
    return b;
}
__device__ __forceinline__ void xcd_barrier_complete(unsigned* bar, unsigned x, unsigned& nloc, unsigned& nx) {
    const unsigned G = gridDim.x * gridDim.y * gridDim.z;
    unsigned sum, cnt, mine, sp = 0u;
    for (;;) {
        sum = 0u; cnt = 0u; mine = 0u;
#pragma unroll
        for (unsigned j = 0; j < 16; ++j) { const unsigned c = xb_ld(&bar[XB_XCNT(j)]); sum += c; cnt += (c > 0u) ? 1u : 0u; mine = (j == x) ? c : mine; }
        if (sum == G) break;
        __builtin_amdgcn_s_sleep(1);
        if ((++sp & 255u) == 0u) { if (xb_ld(&bar[XB_TMO])) break; if (sp > XB_SPIN_CAP) { atomicAdd(&bar[XB_TMO], 1u); break; } }
    }
    nloc = mine > 0u ? mine : 1u; nx = cnt > 0u ? cnt : 1u;
}

__device__ __forceinline__ void xcd_barrier(const XcdBarrier& b) {
    asm volatile("s_waitcnt vmcnt(0)" ::: "memory");
    __syncthreads();
    if (b.wave == 0 && pg8::fresh_lane() == 0) {
        unsigned* bar = b.bar;
        __builtin_amdgcn_s_waitcnt(0);
        unsigned nloc = b.st[0], nx = b.st[1];
        if (nloc == 0u) { xcd_barrier_complete(bar, b.x, nloc, nx); b.st[0] = nloc; b.st[1] = nx; }
        const unsigned old = xb_add(&bar[XB_XSUB(b.x)], 1u);
        const unsigned gen = old / nloc;
        if (old + 1u == (gen + 1u) * nloc) {
            __builtin_amdgcn_fence(__ATOMIC_RELEASE, "agent");
            asm volatile("s_waitcnt vmcnt(0)" ::: "memory");
            const unsigned og = xb_add(&bar[XB_TOP], 1u);
            const unsigned tg = og / nx;
            if (og + 1u == (tg + 1u) * nx) xb_add(&bar[XB_TOPGEN], 1u);
            else XB_SPIN(xb_ld(&bar[XB_TOPGEN]) == tg, bar);
            __builtin_amdgcn_fence(__ATOMIC_ACQUIRE, "agent");
            xb_add(&bar[XB_XGEN(b.x)], 1u);
            asm volatile("s_waitcnt vmcnt(0)" ::: "memory");
        } else {
            XB_SPIN(xb_ld(&bar[XB_XGEN(b.x)]) == gen, bar);
            __builtin_amdgcn_fence(__ATOMIC_ACQUIRE, "agent");
            asm volatile("s_waitcnt vmcnt(0)" ::: "memory");
        }
    }
    __syncthreads();
}

struct Frame {
    LAS unsigned char* lds;
    volatile LAS unsigned* MISC;
    int tid, lane, wave;
    int vcu, G;
    const float *x, *p, *mix_norm, *w_in, *b_f, *conv_w, *mix_out_norm, *w_o, *ffn_norm, *w_gu, *w_d, *ple_norm, *w_pg, *b_pg, *w_pp, *final_norm;
    float* out;
    bf16 *Win_t, *Wo_t, *Wgu_t, *Wd_t, *Wpg_t, *Wpp_t;
    float *LF, *CL, *SSQ1, *SSQ2;
    bf16 *PB, *XN, *Z, *Y, *PROJ;
    unsigned char* ws;
};
__device__ __forceinline__ float wave_sum(float v) {
#define WS_DPP(x, ctrl) __int_as_float(__builtin_amdgcn_update_dpp(0, __float_as_int(x), (ctrl), 0xf, 0xf, true))
    v += WS_DPP(v, 0xB1); v += WS_DPP(v, 0x4E); v += WS_DPP(v, 0x141); v += WS_DPP(v, 0x140);
#undef WS_DPP
    v += __int_as_float(__builtin_amdgcn_ds_swizzle(__float_as_int(v), (16 << 10) | 0x1f));
    { auto rr = __builtin_amdgcn_permlane32_swap(__float_as_uint(v), __float_as_uint(v), false, false); v = __uint_as_float(rr[0]) + __uint_as_float(rr[1]); }
    return v;
}
__device__ __forceinline__ void p0_transpose_item(const float* W, int ldw, int K, bf16* WT, int k0, int n0src, int drow0, const float* gain, LAS float* scr, int lane) {
    const int kq = lane >> 3, nq = (lane & 7) * 4;
    f32x4 v[8];
#pragma unroll
    for (int i = 0; i < 8; ++i) v[i] = *(const GAS f32x4*)(W + (size_t)(k0 + 8 * i + kq) * ldw + n0src + nq);
#pragma unroll
    for (int i = 0; i < 8; ++i) { const int kk = 8 * i + kq; f32x4 x = v[i]; if (gain) x = x * gain[k0 + kk];
        scr[kk * 33 + nq] = x.x; scr[kk * 33 + nq + 1] = x.y; scr[kk * 33 + nq + 2] = x.z; scr[kk * 33 + nq + 3] = x.w; }
    LDS_WAIT(); asm volatile("" ::: "memory");
    const int c = lane & 7;
#pragma unroll
    for (int j = 0; j < 4; ++j) { const int n = (lane >> 3) + 8 * j; const LAS float* s = scr + (8 * c) * 33 + n;
        v4u o; o.x = pk2(s[0 * 33], s[1 * 33]); o.y = pk2(s[2 * 33], s[3 * 33]); o.z = pk2(s[4 * 33], s[5 * 33]); o.w = pk2(s[6 * 33], s[7 * 33]);
        *(GAS v4u*)(WT + (size_t)(drow0 + n) * K + k0 + 8 * c) = o; }
    LDS_WAIT(); asm volatile("" ::: "memory");
}
__device__ __forceinline__ float log_sigmoid_f(float v) { return v < 0.f ? v - log1pf(expf(v)) : -log1pf(expf(-v)); }
__device__ __forceinline__ void p0_row(Frame& F, int m, const f32x4 (&gw)[8][4], const f32x4 (&g)[4], const f32x4 (&v)[4]) {
    float s = 0.f, zf[8];
#pragma unroll
    for (int h = 0; h < 8; ++h) zf[h] = 0.f;
#pragma unroll
    for (int j = 0; j < 4; ++j) { s += (v[j].x * v[j].x + v[j].y * v[j].y) + (v[j].z * v[j].z + v[j].w * v[j].w);
#pragma unroll
        for (int h = 0; h < 8; ++h) zf[h] += (v[j].x * gw[h][j].x + v[j].y * gw[h][j].y) + (v[j].z * gw[h][j].z + v[j].w * gw[h][j].w); }
    const float irs = sqrtf(wave_sum(s) * (1.f / DM) + EPS), rstd = 1.f / irs;
    if (F.lane == 0) ((float*)(F.ws + WS_IRX))[m] = irs;
    GAS unsigned long long* o8 = (GAS unsigned long long*)(F.XN + (size_t)m * DM) + F.lane;
#pragma unroll
    for (int j = 0; j < 4; ++j) { const f32x4 xn = v[j] * rstd; o8[64 * j] = (unsigned long long)pk2(xn.x, xn.y) | ((unsigned long long)pk2(xn.z, xn.w) << 32); }
#pragma unroll
    for (int h = 0; h < 8; ++h) zf[h] = wave_sum(zf[h]);
    float mine = zf[0];
#pragma unroll
    for (int h = 1; h < 8; ++h) mine = (F.lane == h) ? zf[h] : mine;
    if (F.lane < 8) { const int b = m / SEQ, sp = m % SEQ; F.LF[((size_t)(b * NH + F.lane)) * SEQ + sp] = log_sigmoid_f(mine * rstd + F.b_f[F.lane]); }
}
__device__ __forceinline__ void p0_prologue(Frame& F) {
    LAS float* scr = (LAS float*)(F.lds + RING_OFF + F.wave * 16384);
    const int gw = F.vcu * NWAVES + F.wave, NGW = F.G * NWAVES;
    constexpr int I_IN = 16 * 96, I_O = 16 * 32, I_GU = 16 * 176, I_D = 44 * 32, I_PG = 16 * 32, I_PP = 4 * 32;
    constexpr int NITEMS = I_IN + I_O + I_GU + I_D + I_PG + I_PP;
    for (int it = gw; it < NITEMS; it += NGW) {
        int r = it;
        if (r < I_IN) { const int kb = r / 96, nb = r % 96, n0 = 32 * nb; int drow = n0;
                        if (n0 >= 512 && n0 < 1536) { const int bjj = n0 >= 1024 ? 1 : 0, ch0 = n0 - 512 - 512 * bjj; drow = 256 * (2 + ch0 / 128) + 64 * ((ch0 % 128) / 32) + 32 * bjj; }
                        p0_transpose_item(F.w_in, INC, DM, F.Win_t, 64 * kb, n0, drow, F.mix_norm, scr, F.lane); continue; } r -= I_IN;
        if (r < I_O)  { const int kb = r / 32, nb = r % 32; p0_transpose_item(F.w_o, DM, DM, F.Wo_t, 64 * kb, 32 * nb, 32 * nb, nullptr, scr, F.lane); continue; } r -= I_O;
        if (r < I_GU) { const int kb = r / 176, nb = r % 176, n0 = 32 * nb, up = n0 >= FF ? 1 : 0, j = n0 - up * FF; const int drow = 256 * (j / 128) + 128 * up + (j % 128);
                        p0_transpose_item(F.w_gu, 2 * FF, DM, F.Wgu_t, 64 * kb, n0, drow, F.ffn_norm, scr, F.lane); continue; } r -= I_GU;
        if (r < I_D)  { const int kb = r / 32, nb = r % 32; p0_transpose_item(F.w_d, DM, FF, F.Wd_t, 64 * kb, 32 * nb, 32 * nb, nullptr, scr, F.lane); continue; } r -= I_D;
        if (r < I_PG) { const int kb = r / 32, nb = r % 32; p0_transpose_item(F.w_pg, DM, DM, F.Wpg_t, 64 * kb, 32 * nb, 32 * nb, F.ple_norm, scr, F.lane); continue; } r -= I_PG;
        { const int kb = r / 32, nb = r % 32; p0_transpose_item(F.w_pp, DM, PLE, F.Wpp_t, 64 * kb, 32 * nb, 32 * nb, nullptr, scr, F.lane); }
    }
    __syncthreads();
    LAS float* wfT = (LAS float*)(F.lds + RING_OFF);
    for (int e = F.tid; e < 8 * DM; e += NWAVES * 64) { const int k = e >> 3, h = e & 7; wfT[h * DM + k] = F.w_in[(size_t)k * INC + 3072 + h]; }
    __syncthreads();
    {
        f32x4 g[4], gwv[8][4];
#pragma unroll
        for (int j = 0; j < 4; ++j) { g[j] = ((const GAS f32x4*)F.mix_norm)[F.lane + 64 * j];
#pragma unroll
            for (int h = 0; h < 8; ++h) gwv[h][j] = *(const LAS f32x4*)(wfT + h * 1024 + 256 * j + 4 * F.lane) * g[j]; }
        f32x4 va[2][4], vb[2][4];
#define P0_LD(dst, m0_) do { _Pragma("unroll") for (int r = 0; r < 2; ++r) { const GAS f32x4* xr = (const GAS f32x4*)(F.x + (size_t)((m0_) + r) * DM) + F.lane; \
            _Pragma("unroll") for (int j = 0; j < 4; ++j) dst[r][j] = __builtin_nontemporal_load(xr + 64 * j); } } while (0)
        int m0 = gw * 2; const int mstep = NGW * 2;
        if (m0 < MTOK) P0_LD(va, m0);
        for (; m0 < MTOK; m0 += 2 * mstep) {
            const int m1 = m0 + mstep, m2 = m0 + 2 * mstep;
            if (m1 < MTOK) P0_LD(vb, m1);
#pragma unroll
            for (int r = 0; r < 2; ++r) p0_row(F, m0 + r, gwv, g, va[r]);
            if (m1 < MTOK) { if (m2 < MTOK) P0_LD(va, m2);
#pragma unroll
                for (int r = 0; r < 2; ++r) p0_row(F, m1 + r, gwv, g, vb[r]); }
        }
#undef P0_LD
    }
    { const GAS f32x4* p4 = (const GAS f32x4*)F.p; GAS unsigned long long* o8 = (GAS unsigned long long*)F.PB; const size_t n4 = (size_t)MTOK * PLE / 4, nthr = (size_t)F.G * (NWAVES * 64);
      for (size_t i = (size_t)blockIdx.x * (NWAVES * 64) + F.tid; i < n4; i += nthr * 8) { f32x4 v[8];
#pragma unroll
          for (int k = 0; k < 8; ++k) v[k] = __builtin_nontemporal_load(p4 + i + k * nthr);
#pragma unroll
          for (int k = 0; k < 8; ++k) o8[i + k * nthr] = (unsigned long long)pk2(v[k].x, v[k].y) | ((unsigned long long)pk2(v[k].z, v[k].w) << 32); } }
    __syncthreads();
}
__device__ __forceinline__ void scan_phase(Frame& F) {
    for (int seq = blockIdx.x; seq < NB * NH; seq += F.G) {
        const float* src = F.LF + (size_t)seq * SEQ + F.tid * 8;
        const f32x4 a = *(const f32x4*)src, b = *(const f32x4*)(src + 4);
        float pr[8]; pr[0] = a.x; pr[1] = pr[0] + a.y; pr[2] = pr[1] + a.z; pr[3] = pr[2] + a.w; pr[4] = pr[3] + b.x; pr[5] = pr[4] + b.y; pr[6] = pr[5] + b.z; pr[7] = pr[6] + b.w;
        const float tot = pr[7]; float inc = tot;
#pragma unroll
        for (int o = 1; o < 64; o <<= 1) { const float t = __shfl_up(inc, o); if (F.lane >= o) inc += t; }
        LAS float* wt = (LAS float*)(F.lds + RING_OFF);
        if (F.lane == 63) wt[F.wave] = inc;
        __syncthreads();
        float woff = 0.f;
#pragma unroll
        for (int w = 0; w < NWAVES; ++w) { const float t = wt[w]; if (w < F.wave) woff += t; }
        const float excl = woff + (inc - tot);
        float* dst = F.CL + (size_t)seq * SEQ + F.tid * 8;
        *(f32x4*)dst = (f32x4){(excl + pr[0]) * LOG2E, (excl + pr[1]) * LOG2E, (excl + pr[2]) * LOG2E, (excl + pr[3]) * LOG2E};
        *(f32x4*)(dst + 4) = (f32x4){(excl + pr[4]) * LOG2E, (excl + pr[5]) * LOG2E, (excl + pr[6]) * LOG2E, (excl + pr[7]) * LOG2E};
        __syncthreads();
    }
}
__device__ __forceinline__ void conv_phase(Frame& F) {
    const int ch = 8 * F.lane;
    float w0[8], w1[8], w2[8], gn[8];
    { const f32x4 a0 = *(const f32x4*)(F.conv_w + ch), a1 = *(const f32x4*)(F.conv_w + ch + 4), b0 = *(const f32x4*)(F.conv_w + 512 + ch), b1 = *(const f32x4*)(F.conv_w + 512 + ch + 4),
                  c0 = *(const f32x4*)(F.conv_w + 1024 + ch), c1 = *(const f32x4*)(F.conv_w + 1024 + ch + 4), g0 = *(const f32x4*)(F.mix_out_norm + ch), g1 = *(const f32x4*)(F.mix_out_norm + ch + 4);
#pragma unroll
      for (int i = 0; i < 4; ++i) { w0[i] = a0[i]; w0[4 + i] = a1[i]; w1[i] = b0[i]; w1[4 + i] = b1[i]; w2[i] = c0[i]; w2[4 + i] = c1[i]; gn[i] = g0[i]; gn[4 + i] = g1[i]; } }
#define UNPK8(dst, PKV) do { dst[0] = pg8::bf_lo(PKV.x); dst[1] = pg8::bf_hi(PKV.x); dst[2] = pg8::bf_lo(PKV.y); dst[3] = pg8::bf_hi(PKV.y); dst[4] = pg8::bf_lo(PKV.z); dst[5] = pg8::bf_hi(PKV.z); dst[6] = pg8::bf_lo(PKV.w); dst[7] = pg8::bf_hi(PKV.w); } while (0)
    unsigned* qctr = (unsigned*)(F.ws + WS_CTL + CTL_CONVQ);
    for (;;) {
        int chunk = 0; if (F.lane == 0) chunk = (int)__hip_atomic_fetch_add(qctr, 1u, __ATOMIC_RELAXED, __HIP_MEMORY_SCOPE_AGENT);
        chunk = __builtin_amdgcn_readfirstlane(chunk);
        if (chunk >= MTOK / 32) break;
        const int r0 = chunk * 32, s0 = r0 % SEQ;
        float cu1[8], cu2[8];
#pragma unroll
        for (int i = 0; i < 8; ++i) { cu1[i] = 0.f; cu2[i] = 0.f; }
        const bf16* CUB = (const bf16*)(F.ws + WS_CUB);
        if (s0 > 0) {
            const v4u c2w = *(const v4u*)(CUB + (size_t)(r0 - 2) * 512 + ch), c1w = *(const v4u*)(CUB + (size_t)(r0 - 1) * 512 + ch);
            UNPK8(cu2, c2w); UNPK8(cu1, c1w);
        }
#pragma unroll 4
        for (int t = 0; t < 32; ++t) {
            const bf16* zr = F.Z + (size_t)(r0 + t) * NZ + ch;
            const v4u bw = __builtin_nontemporal_load((const v4u*)zr), cw = __builtin_nontemporal_load((const v4u*)(CUB + (size_t)(r0 + t) * 512 + ch));
            float gb[8], gcu[8], yv[8]; UNPK8(gb, bw); UNPK8(gcu, cw);
            float ss = 0.f;
#pragma unroll
            for (int i = 0; i < 8; ++i) { const float cu0 = gcu[i]; const float cv = w0[i] * cu2[i] + w1[i] * cu1[i] + w2[i] * cu0; yv[i] = gb[i] * cv; ss += yv[i] * yv[i]; cu2[i] = cu1[i]; cu1[i] = cu0; }
            ss = pg8::sum_row8(ss);
            const float rs = 1.f / sqrtf(ss * (1.0f / 64.0f) + EPS);
            v4u o; o.x = pk2(yv[0] * rs * gn[0], yv[1] * rs * gn[1]); o.y = pk2(yv[2] * rs * gn[2], yv[3] * rs * gn[3]); o.z = pk2(yv[4] * rs * gn[4], yv[5] * rs * gn[5]); o.w = pk2(yv[6] * rs * gn[6], yv[7] * rs * gn[7]);
            *(GAS v4u*)(F.Y + (size_t)(r0 + t) * DM + ch) = o;
        }
    }
#undef UNPK8
}
__device__ __forceinline__ void final_phase(Frame& F) {
    const int gw = F.vcu * NWAVES + F.wave, NGW = F.G * NWAVES;
    typedef unsigned u32x2_t __attribute__((ext_vector_type(2)));
    f32x4 g[4];
#pragma unroll
    for (int j = 0; j < 4; ++j) g[j] = ((const GAS f32x4*)F.final_norm)[F.lane + 64 * j];
    for (int m0 = gw * 16; m0 < MTOK; m0 += NGW * 16) {
        u32x2_t w[16][4];
#pragma unroll
        for (int r = 0; r < 16; ++r) { const GAS u32x2_t* hr = (const GAS u32x2_t*)(F.XN + (size_t)(m0 + r) * DM) + F.lane;
#pragma unroll
            for (int j = 0; j < 4; ++j) w[r][j] = hr[64 * j]; }
#pragma unroll
        for (int r = 0; r < 16; ++r) { f32x4 v[4]; float s = 0.f;
#pragma unroll
            for (int j = 0; j < 4; ++j) { v[j] = (f32x4){pg8::bf_lo(w[r][j].x), pg8::bf_hi(w[r][j].x), pg8::bf_lo(w[r][j].y), pg8::bf_hi(w[r][j].y)}; s += (v[j].x * v[j].x + v[j].y * v[j].y) + (v[j].z * v[j].z + v[j].w * v[j].w); }
            const float rstd = 1.f / sqrtf(wave_sum(s) * (1.f / DM) + EPS);
            GAS f32x4* orow = (GAS f32x4*)(F.out + (size_t)(m0 + r) * DM) + F.lane;
#pragma unroll
            for (int j = 0; j < 4; ++j) orow[64 * j] = v[j] * rstd * g[j]; }
    }
}
__device__ __forceinline__ void attn_phase(Frame& F, char* ldsbase, const float* KN, const float* QN) {
    const attn_body::bf16* Zb = (const attn_body::bf16*)F.Z;
    const int g = F.vcu >> 3, j = F.vcu & 7;
    if (F.G == 256) {
        const int h0 = g & 7, bs = g >> 3;
        volatile LAS unsigned* T0 = F.MISC + 16;
#define ATT_UNIT_OF(u_, b_, hh_, qb_) const int r_ = (u_) >> 1, hh_ = (r_ == 0) ? h0 : (r_ == 1) ? 7 - h0 : (r_ == 2) ? ((h0 + 4) & 7) : 7 - ((h0 + 4) & 7), \
            jj_ = (r_ == 0) ? j : (r_ == 1) ? 7 - j : (r_ == 2) ? ((j + 4) & 7) : 7 - ((j + 4) & 7), b_ = 4 * r_ + bs, qb_ = ((u_) & 1) ? 15 - jj_ : jj_
        {
            const int u = F.wave; ATT_UNIT_OF(u, b, hh, qb); const int bh = b * NH + hh;
            const int t0 = attn_body::attn_skip_t0(qb, F.CL + (size_t)bh * SEQ, KN + (size_t)bh * 128, QN + ((size_t)bh * 16 + qb) * 2, F.lane);
            if (F.lane == 0) T0[u] = (unsigned)t0;
        }
        __syncthreads();
        for (int u = 0; u < 8; ++u) { ATT_UNIT_OF(u, b, hh, qb); const int bh = b * NH + hh; const int t0 = __builtin_amdgcn_readfirstlane((int)T0[u]);
            attn_body::attn_unit<8>(b, hh, qb, Zb + 1536, Zb + 2048, Zb + 2560, (attn_body::bf16*)F.Y + 512, F.CL + (size_t)bh * SEQ, F.mix_out_norm + 512 + hh * HD, t0, ldsbase, F.wave); }
#undef ATT_UNIT_OF
    } else {
        const int per = F.G >> 3;
        for (int bh = g; bh < NB * NH; bh += per) { const int b = bh / NH, h = bh % NH;
            for (int i = 0; i < 2; ++i) { const int qb = i ? 15 - j : j;
                const int t0 = attn_body::attn_skip_t0(qb, F.CL + (size_t)bh * SEQ, KN + (size_t)bh * 128, QN + ((size_t)bh * 16 + qb) * 2, F.lane);
                attn_body::attn_unit<8>(b, h, qb, Zb + 1536, Zb + 2048, Zb + 2560, (attn_body::bf16*)F.Y + 512, F.CL + (size_t)bh * SEQ, F.mix_out_norm + 512 + h * HD, t0, ldsbase, F.wave); } }
    }
}

__device__ __forceinline__ bool fill_rstd_table(Frame& F, const float* SSQ, const pg8::StaticOrder& S, LAS float* tab) {
    if (F.G != 256 || S.nM != 256) return false;
    int pms[4] = {-1, -1, -1, -1};
    { pg8::Unit u; for (int i = 0; S.next(i, u); ++i) { const int sl = (u.pm >> 3) & 3;
#pragma unroll
          for (int q = 0; q < 4; ++q) if (q == sl) pms[q] = u.pm; } }
    if (F.tid < 256) {
#pragma unroll
        for (int q = 0; q < 4; ++q) { if (pms[q] < 0) continue; const f32x4* p = (const f32x4*)(SSQ + (size_t)(pms[q] * 256 + F.tid) * 16); const f32x4 a = (p[0] + p[1]) + (p[2] + p[3]);
            tab[q * 256 + F.tid] = __builtin_amdgcn_rsqf(((a[0] + a[1]) + (a[2] + a[3])) * (1.0f / 1024.0f) + 1e-6f); } }
    __syncthreads();
    return true;
}
struct Args { const float* in[16]; float* out; unsigned char* ws; int ph_lo, ph_hi, rep, pad; };
__device__ __forceinline__ void load_ptrs(Frame& F) {
    const __attribute__((address_space(4))) Args* ap = (const __attribute__((address_space(4))) Args*)__builtin_amdgcn_kernarg_segment_ptr();
    asm volatile("" : "+s"(ap));
    unsigned char* ws = ap->ws;
    F.x = ap->in[0]; F.p = ap->in[1]; F.mix_norm = ap->in[2]; F.w_in = ap->in[3]; F.b_f = ap->in[4]; F.conv_w = ap->in[5]; F.mix_out_norm = ap->in[6]; F.w_o = ap->in[7];
    F.ffn_norm = ap->in[8]; F.w_gu = ap->in[9]; F.w_d = ap->in[10]; F.ple_norm = ap->in[11]; F.w_pg = ap->in[12]; F.b_pg = ap->in[13]; F.w_pp = ap->in[14]; F.final_norm = ap->in[15];
    F.out = ap->out;
    F.Win_t = (bf16*)(ws + WS_WIN); F.Wo_t = (bf16*)(ws + WS_WO); F.Wgu_t = (bf16*)(ws + WS_WGU); F.Wd_t = (bf16*)(ws + WS_WD); F.Wpg_t = (bf16*)(ws + WS_WPG); F.Wpp_t = (bf16*)(ws + WS_WPP);
    F.LF = (float*)(ws + WS_LF); F.CL = (float*)(ws + WS_CL); F.SSQ1 = (float*)(ws + WS_SSQ1); F.SSQ2 = (float*)(ws + WS_SSQ2);
    F.PB = (bf16*)(ws + WS_PB); F.XN = (bf16*)(ws + WS_XN); F.Z = (bf16*)(ws + WS_Z); F.Y = (bf16*)(ws + WS_Y); F.PROJ = (bf16*)(ws + WS_PROJ);
    F.ws = ws;
}
constexpr int N_PHASES = 11;
__global__ void __launch_bounds__(NWAVES * 64, 2) mega_fwd(Args args) {
    extern __shared__ __attribute__((aligned(16))) unsigned char lds[];
    Frame F;
    F.lds = (LAS unsigned char*)lds;
    F.MISC = (volatile LAS unsigned*)(F.lds + MISC_OFF);
    F.tid = threadIdx.x; F.lane = F.tid & 63; F.wave = __builtin_amdgcn_readfirstlane(F.tid >> 6);
    F.G = gridDim.x; { const int bx = blockIdx.x; F.vcu = (F.G % 8 == 0) ? (bx % 8) * (F.G / 8) + bx / 8 : bx; }
    unsigned char* ws = args.ws;
    load_ptrs(F);
    for (int u = F.tid; u < (LDS_BYTES - LDSCTL_OFF) / 4; u += NWAVES * 64) ((LAS unsigned*)(F.lds + LDSCTL_OFF))[u] = 0u;
    __syncthreads();
    const int lo = args.ph_lo, hi = args.ph_hi;
    XcdBarrier bar; bar.wave = F.wave; bar.bar = (unsigned*)((gu32*)(ws + WS_CTL) + CW_BAR); bar.x = 0; bar.st = nullptr;
    const bool multi = (hi - lo) > 1;
    if (multi) bar = xcd_barrier_post((unsigned*)(ws + WS_CTL) + CW_BAR, F.MISC + 8, F.wave);
#ifndef PH_MASK
#define PH_MASK 0x7ff
#endif
#define IN(k) ((((PH_MASK) >> (k)) & 1) && lo <= (k) && (k) < hi)
#define SEAM(k) do { if (IN(k) && IN((k) + 1)) xcd_barrier(bar); } while (0)

#define PH(k, ...) do { const int np_ = 1 + ((args.rep == (k)) ? 1 : 0); for (int pass_ = 0; pass_ < np_; ++pass_) { if (IN(k)) { { int t_ = F.wave * 64 + pg8::fresh_lane(); asm volatile("" : "+v"(t_)); F.tid = t_; F.lane = t_ & 63; load_ptrs(F); }     \
        __VA_ARGS__ } if (pass_ + 1 < np_) xcd_barrier(bar); } } while (0)
    PH(0, p0_prologue(F);); SEAM(0);
    PH(1, scan_phase(F););
    PH(2,
        pg8::Gemm g{F.XN, F.Win_t, MTOK, NZ, DM}; pg8::StaticOrder S; S.init(MTOK, NZ, F.G, (int)blockIdx.x);
        pg8::EpiBf16Plain E{F.Z, NZ, 6, 8, QSCALE, (unsigned*)(F.ws + WS_CTL + CTL_KN), (unsigned*)(F.ws + WS_CTL + CTL_QN), (bf16*)(F.ws + WS_CUB)};
        pg8::gemm_phase<pg8::EpiBf16Plain, pg8::StaticOrder, PG8_ALIGN, PG8_SP2>(F.lds + RING_OFF, g, S, E, F.wave);
    ); SEAM(2);
    PH(3, attn_phase(F, (char*)lds + RING_OFF, (const float*)(F.ws + WS_CTL + CTL_KN), (const float*)(F.ws + WS_CTL + CTL_QN)););
    PH(4, conv_phase(F);); SEAM(4);
    PH(5,
        pg8::Gemm g{F.Y, F.Wo_t, MTOK, DM, DM}; pg8::StaticOrder S; S.init(MTOK, DM, F.G, (int)blockIdx.x);
        pg8::EpiRes<true> E{F.XN, F.XN, F.SSQ1, (const float*)(F.ws + WS_IRX)};
        pg8::gemm_phase<pg8::EpiRes<true>, pg8::StaticOrder, PG8_ALIGN, PG8_SP2>(F.lds + RING_OFF, g, S, E, F.wave);
    ); SEAM(5);
    PH(6,
        pg8::Gemm g{F.XN, F.Wgu_t, MTOK, 2 * FF, DM}; pg8::StaticOrder S; S.init(MTOK, 2 * FF, F.G, (int)blockIdx.x); S.rev = 1;
        LAS float* rt = (LAS float*)(F.lds + SPARE_OFF); const bool ok = fill_rstd_table(F, F.SSQ1, S, rt);
        pg8::EpiSwiglu E{F.Z, F.SSQ1, ok ? rt : nullptr};
        pg8::gemm_phase<pg8::EpiSwiglu, pg8::StaticOrder, PG8_ALIGN, PG8_SP2>(F.lds + RING_OFF, g, S, E, F.wave);
    ); SEAM(6);
    PH(7,
        pg8::Gemm g{F.Z, F.Wd_t, MTOK, DM, FF}; pg8::StaticOrder S; S.init(MTOK, DM, F.G, (int)blockIdx.x);
        pg8::EpiRes<false> E{F.XN, F.Y, F.SSQ2, nullptr};
        pg8::gemm_phase<pg8::EpiRes<false>, pg8::StaticOrder, PG8_ALIGN, PG8_SP2>(F.lds + RING_OFF, g, S, E, F.wave);
    );
    PH(8,
        pg8::Gemm g{F.PB, F.Wpp_t, MTOK, DM, PLE}; pg8::StaticOrder S; S.init(MTOK, DM, F.G, (int)blockIdx.x);
        pg8::EpiBf16Plain E{F.PROJ, DM, 0, 0, 1.f, nullptr, nullptr, nullptr};
        pg8::gemm_phase<pg8::EpiBf16Plain, pg8::StaticOrder, PG8_ALIGN, PG8_SP2>(F.lds + RING_OFF, g, S, E, F.wave);
    ); SEAM(8);
    PH(9,
        pg8::Gemm g{F.Y, F.Wpg_t, MTOK, DM, DM}; pg8::StaticOrder S; S.init(MTOK, DM, F.G, (int)blockIdx.x); S.rev = 1;
        LAS float* rt = (LAS float*)(F.lds + SPARE_OFF); const bool ok = fill_rstd_table(F, F.SSQ2, S, rt);
        pg8::EpiPle E{F.Y, F.PROJ, F.SSQ2, F.b_pg, F.XN, ok ? rt : nullptr};
        pg8::gemm_phase<pg8::EpiPle, pg8::StaticOrder, PG8_ALIGN, PG8_SP2>(F.lds + RING_OFF, g, S, E, F.wave);
    ); SEAM(9);
    PH(10, final_phase(F););
#undef PH
#undef IN
#undef SEAM
}

namespace naive {
typedef short bf16x8 __attribute__((ext_vector_type(8)));
typedef float f32x4 __attribute__((ext_vector_type(4)));
__device__ __forceinline__ float bf2f(unsigned short h) { return __uint_as_float((unsigned)h << 16); }
__device__ __forceinline__ unsigned short f2bf16(float f) { return (unsigned short)f2bf(f); }
struct NArgs { const unsigned short* A; const unsigned short* Bt; int M, N, K; int kind;
               const float* X; const unsigned short* Hin; unsigned short* Hout; const float* SSQ; const unsigned short* PROJ; const float* bg; float* OUT; };
__device__ __forceinline__ float nrstd(const float* ssq, int row) { float s = 0.f; for (int i = 0; i < 16; ++i) s += ssq[(size_t)row * 16 + i]; return 1.f / sqrtf(s * (1.f / 1024.f) + 1e-6f); }
__device__ __forceinline__ float nsig(float v) { return 1.f / (1.f + expf(-v)); }
__global__ void __launch_bounds__(256) naive_gemm(NArgs a) {
    const int lane = threadIdx.x & 63, w = threadIdx.x >> 6, fr = lane & 15, fq = lane >> 4;
    const int m0 = blockIdx.y * 64 + 16 * w, n0 = blockIdx.x * 64;
    f32x4 acc[4], acc2[4];
    for (int j = 0; j < 4; ++j) { acc[j] = (f32x4){0.f, 0.f, 0.f, 0.f}; acc2[j] = (f32x4){0.f, 0.f, 0.f, 0.f}; }
    const bool dual = a.kind == 6;
    for (int k0 = 0; k0 < a.K; k0 += 32) {
        const bf16x8 af = *(const bf16x8*)(a.A + (size_t)(m0 + fr) * a.K + k0 + 8 * fq);
        for (int j = 0; j < 4; ++j) {
            const int col = n0 + 16 * j + fr;
            int brow = col;
            if (dual) brow = 256 * (col / 128) + (col % 128);
            const bf16x8 bf = *(const bf16x8*)(a.Bt + (size_t)brow * a.K + k0 + 8 * fq);
            acc[j] = __builtin_amdgcn_mfma_f32_16x16x32_bf16(af, bf, acc[j], 0, 0, 0);
            if (dual) { const bf16x8 bf2 = *(const bf16x8*)(a.Bt + (size_t)(brow + 128) * a.K + k0 + 8 * fq); acc2[j] = __builtin_amdgcn_mfma_f32_16x16x32_bf16(af, bf2, acc2[j], 0, 0, 0); }
        }
    }
    for (int j = 0; j < 4; ++j)
        for (int r = 0; r < 4; ++r) {
            const int row = m0 + 4 * fq + r, col = n0 + 16 * j + fr; const float v = acc[j][r];
            switch (a.kind) {
                case 2: a.Hout[(size_t)row * 3072 + col] = f2bf16(v * ((col >= 1536 && col < 2048) ? QSCALE : 1.f)); break;
                case 5: a.Hout[(size_t)row * 1024 + col] = f2bf16(a.X[(size_t)row * 1024 + col] + v); break;
                case 6: { const float rs = nrstd(a.SSQ, row), g = v * rs, u = acc2[j][r] * rs; a.Hout[(size_t)row * 2816 + col] = f2bf16(g * nsig(g) * u); } break;
                case 7: a.Hout[(size_t)row * 1024 + col] = f2bf16(bf2f(a.Hin[(size_t)row * 1024 + col]) + v); break;
                case 8: a.Hout[(size_t)row * 1024 + col] = f2bf16(v); break;
                case 9: { const float rs = nrstd(a.SSQ, row); a.Hout[(size_t)row * 1024 + col] = f2bf16(bf2f(a.Hin[(size_t)row * 1024 + col]) + nsig(v * rs + a.bg[col]) * bf2f(a.PROJ[(size_t)row * 1024 + col])); } break;
            }
        }
}
__global__ void __launch_bounds__(256) naive_ssq(const unsigned short* H, float* SSQ) {
    const int row = blockIdx.x * 4 + (threadIdx.x >> 6), lane = threadIdx.x & 63; float s = 0.f;
    for (int c = lane; c < 1024; c += 64) { const float v = bf2f(H[(size_t)row * 1024 + c]); s += v * v; }
    for (int o = 1; o < 64; o <<= 1) s += __shfl_xor(s, o);
    if (lane < 16) SSQ[(size_t)row * 16 + lane] = lane == 0 ? s : 0.f;
}
__global__ void __launch_bounds__(64) naive_attn(const unsigned short* Z, const float* CL, const float* gout_all, unsigned short* Y) {
    __shared__ float Ks[64][64]; __shared__ float Vs[64][64]; __shared__ float Sc[64][64];
    const int tid = threadIdx.x, qblk = blockIdx.x % (SEQ / 64), bh = blockIdx.x / (SEQ / 64), b = bh / NH, h = bh % NH;
    const int t = qblk * 64 + tid; const size_t row = (size_t)b * SEQ + t;
    float q[64], o[64];
#pragma unroll
    for (int d = 0; d < 64; ++d) { q[d] = bf2f(Z[row * 3072 + 1536 + h * 64 + d]); o[d] = 0.f; }
    const float* cl = CL + (size_t)bh * SEQ; const float clq = cl[t];
    float m_run = -INFINITY, l = 0.f;
    for (int kt = 0; kt <= qblk; ++kt) {
        __syncthreads();
        { const size_t kr = (size_t)b * SEQ + kt * 64 + tid;
#pragma unroll
          for (int d = 0; d < 64; ++d) { Ks[tid][d] = bf2f(Z[kr * 3072 + 2048 + h * 64 + d]); Vs[tid][d] = bf2f(Z[kr * 3072 + 2560 + h * 64 + d]); } }
        __syncthreads();
        float tmax = -INFINITY;
        for (int j = 0; j < 64; ++j) { const int key = kt * 64 + j; float s = 0.f;
#pragma unroll
            for (int d = 0; d < 64; ++d) s += q[d] * Ks[j][d];
            s += clq - cl[key]; if (key > t) s = -INFINITY; Sc[j][tid] = s; tmax = fmaxf(tmax, s); }
        const float m_new = fmaxf(m_run, tmax), sc = exp2f(m_run - m_new); l *= sc;
#pragma unroll
        for (int d = 0; d < 64; ++d) o[d] *= sc;
        m_run = m_new;
        for (int j = 0; j < 64; ++j) { const float p = exp2f(Sc[j][tid] - m_new); l += p;
#pragma unroll
            for (int d = 0; d < 64; ++d) o[d] += p * Vs[j][d]; }
    }
    float ss = 0.f; const float rl = 1.f / l;
#pragma unroll
    for (int d = 0; d < 64; ++d) { o[d] *= rl; ss += o[d] * o[d]; }
    const float rs = 1.f / sqrtf(ss * (1.f / 64.f) + 1e-6f);
#pragma unroll
    for (int d = 0; d < 64; ++d) Y[row * 1024 + 512 + h * 64 + d] = f2bf16(o[d] * rs * gout_all[512 + h * 64 + d]);
}
}

extern "C" void kernel_launch(void* const* d_in, const int* in_sizes, int n_in, void* d_out, int out_size, void* d_ws, size_t ws_size, hipStream_t stream) {
    static int grid = 0;
    if (grid == 0) {
        if (n_in != 16 || in_sizes[0] != MTOK * DM || out_size != MTOK * DM || ws_size < WS_END) { fprintf(stderr, "kernel_launch: unexpected problem shape (n_in %d, in0 %d, out %d, ws %zu); nothing launched\n", n_in, n_in > 0 ? in_sizes[0] : -1, out_size, ws_size); grid = -1; return; }
        int dev = 0, cus = 0;
        if (hipGetDevice(&dev) != hipSuccess || hipDeviceGetAttribute(&cus, hipDeviceAttributeMultiprocessorCount, dev) != hipSuccess) { fprintf(stderr, "kernel_launch: device query failed\n"); grid = -1; return; }
        if (hipFuncSetAttribute((const void*)mega_fwd, hipFuncAttributeMaxDynamicSharedMemorySize, LDS_BYTES) != hipSuccess) { fprintf(stderr, "kernel_launch: hipFuncSetAttribute failed\n"); grid = -1; return; }
        (void)hipGetLastError();
        grid = cus;
        if (grid != 256) fprintf(stderr, "kernel_launch: note: %d CUs\n", grid);
    }
    if (grid < 0) return;
    if (hipMemsetAsync((char*)d_ws + WS_CTL, 0, CTL_ZERO_BYTES, stream) != hipSuccess) { fprintf(stderr, "kernel_launch: memset failed\n"); return; }
    Args a{};
    for (int i = 0; i < 16; ++i) a.in[i] = (const float*)d_in[i];
    a.out = (float*)d_out; a.ws = (unsigned char*)d_ws;
    unsigned char* ws = (unsigned char*)d_ws;
#ifndef PROBE_REP
#define PROBE_REP (-1)
#endif
    a.rep = PROBE_REP; a.pad = 0;
    auto mega = [&](int lo, int hi) { a.ph_lo = lo; a.ph_hi = hi; hipLaunchKernelGGL(mega_fwd, dim3(grid), dim3(NWAVES * 64), LDS_BYTES, stream, a); };
static_assert(((CFG_NAIVE_GEMM >> 2) & 1) == 0, "the reference in-proj kernel does not know the paired gate_c/u weight layout");
#if CFG_ONE_LAUNCH
    mega(0, N_PHASES);
#else
    auto ngemm = [&](int kind) {
        naive::NArgs n{}; n.kind = kind; n.M = MTOK;
        unsigned short* XN = (unsigned short*)(ws + WS_XN); unsigned short* Zp = (unsigned short*)(ws + WS_Z); unsigned short* Yp = (unsigned short*)(ws + WS_Y); unsigned short* PR = (unsigned short*)(ws + WS_PROJ);
        int ncols = 0;
        switch (kind) {
            case 2: n.A = XN; n.Bt = (unsigned short*)(ws + WS_WIN); n.K = DM; n.Hout = Zp; ncols = NZ; break;
            case 5: n.A = Yp; n.Bt = (unsigned short*)(ws + WS_WO); n.K = DM; n.X = (const float*)d_in[0]; n.Hout = XN; ncols = DM; break;
            case 6: n.A = XN; n.Bt = (unsigned short*)(ws + WS_WGU); n.K = DM; n.SSQ = (const float*)(ws + WS_SSQ1); n.Hout = Zp; ncols = FF; break;
            case 7: n.A = Zp; n.Bt = (unsigned short*)(ws + WS_WD); n.K = FF; n.Hin = XN; n.Hout = Yp; ncols = DM; break;
            case 8: n.A = (unsigned short*)(ws + WS_PB); n.Bt = (unsigned short*)(ws + WS_WPP); n.K = PLE; n.Hout = PR; ncols = DM; break;
            case 9: n.A = Yp; n.Bt = (unsigned short*)(ws + WS_WPG); n.K = DM; n.Hin = Yp; n.PROJ = PR; n.SSQ = (const float*)(ws + WS_SSQ2); n.bg = (const float*)d_in[13]; n.Hout = XN; ncols = DM; break;
        }
        n.N = ncols;
        hipLaunchKernelGGL(naive::naive_gemm, dim3(ncols / 64, MTOK / 64), dim3(256), 0, stream, n);
        if (kind == 5) hipLaunchKernelGGL(naive::naive_ssq, dim3(MTOK / 4), dim3(256), 0, stream, (const unsigned short*)XN, (float*)(ws + WS_SSQ1));
        if (kind == 7) hipLaunchKernelGGL(naive::naive_ssq, dim3(MTOK / 4), dim3(256), 0, stream, (const unsigned short*)Yp, (float*)(ws + WS_SSQ2));
    };
    for (int ph = 0; ph < N_PHASES; ++ph) {
        const bool is_gemm = (ph == 2 || ph == 5 || ph == 6 || ph == 7 || ph == 8 || ph == 9);
        if (is_gemm && ((CFG_NAIVE_GEMM >> ph) & 1)) { ngemm(ph); continue; }
        if (ph == 3 && CFG_NAIVE_ATTN) { hipLaunchKernelGGL(naive::naive_attn, dim3(NB * NH * (SEQ / 64)), dim3(64), 0, stream, (const unsigned short*)(ws + WS_Z), (const float*)(ws + WS_CL), (const float*)d_in[6], (unsigned short*)(ws + WS_Y)); continue; }
        mega(ph, ph + 1);
    }
#endif
    const hipError_t le = hipPeekAtLastError();
    if (le != hipSuccess) fprintf(stderr, "kernel_launch: launch failed: %s\n", hipGetErrorName(le));
}
```

```cpp
#include <hip/hip_runtime.h>
#include <hip/hip_bf16.h>
#include <cstdio>
#include <cstdint>
#include <cmath>

constexpr int NB = 16, SEQ = 4096, DM = 1024, MTOK = NB * SEQ, NH = 8, HD = 64, FF = 2816, PLE = 256, NZ = 3072, INC = 3080;
constexpr float EPS = 1e-6f;
constexpr float LOG2E = 1.4426950408889634f;
constexpr float QSCALE = 0.125f * 1.4426950408889634f;
#ifndef CFG_NAIVE_GEMM
#define CFG_NAIVE_GEMM 0
#endif
#ifndef CFG_NAIVE_ATTN
#define CFG_NAIVE_ATTN 0
#endif
#ifndef CFG_ONE_LAUNCH
#define CFG_ONE_LAUNCH 1
#endif

namespace pg8 {
#define PG8_LAS __attribute__((address_space(3)))
typedef unsigned short bf16_t;
typedef short bf16x8 __attribute__((ext_vector_type(8)));
typedef float f32x4 __attribute__((ext_vector_type(4)));
typedef unsigned u32x4 __attribute__((ext_vector_type(4)));
constexpr int BM = 256, BK = 64, HALF = 128, HTB = HALF * BK * 2  , STAGE_BYTES = 8 * HTB, NXCD = 8, WGM = 8;

__host__ __device__ __forceinline__ int lds_byte(int r, int c) { const int st = (r >> 4) * 2 + (c >> 5), rr = r & 15, cc = c & 31, ob = rr * 64 + cc * 2; return st * 1024 + (ob ^ (((ob >> 9) & 1) << 5)); }
__host__ __device__ __forceinline__ void stage_rc(int b, int& R, int& C) { const int st = b / 1024, sb = b % 1024, swz = sb ^ (((sb >> 9) & 1) << 5); R = (st >> 1) * 16 + swz / 64; C = (st & 1) * 32 + (swz % 64) / 2; }
__host__ __device__ __forceinline__ int perm32(int rho) { const int n = rho >> 4, i = rho & 15; return 8 * (i >> 2) + 4 * n + (i & 3); }

struct Unit { int pm, pn; };
struct Gemm { const bf16_t* A; const bf16_t* Bt; int M, N, K; };

struct StaticOrder {
    int nM, nN, nwg, G, c, rev;
    __host__ __device__ void init(int M, int N, int G_, int c_) { nM = M / BM; nN = N / BM; nwg = nM * nN; G = G_; c = c_; rev = 0; }
    __host__ __device__ bool next(int i, Unit& u) const {
        const int nr = (nwg + G - 1) / G; if (i >= nr) return false;
        const long L = (long)(rev ? nr - 1 - i : i) * G + c; if (L >= nwg) return false;
        int wgid = (int)L; { const int q = nwg / NXCD, r = nwg % NXCD, xcd = wgid % NXCD, off = wgid / NXCD; wgid = (xcd < r ? xcd * (q + 1) : r * (q + 1) + (xcd - r) * q) + off; }
        const int nig = WGM * nN, gid = wgid / nig, fm = gid * WGM, gsz = (nM - fm) < WGM ? (nM - fm) : WGM;
        u.pm = fm + ((wgid % nig) % gsz); u.pn = (wgid % nig) / gsz; return true;
    }
    __device__ __forceinline__ void a_ready(const Unit&) const {}
    __device__ __forceinline__ void done(const Unit&) const {}
};

__device__ __forceinline__ unsigned cvt_pk_bf16(float lo, float hi) { unsigned r; asm volatile("v_cvt_pk_bf16_f32 %0, %1, %2" : "=v"(r) : "v"(lo), "v"(hi)); return r; }
typedef float f32x2 __attribute__((ext_vector_type(2)));
typedef unsigned u32x2 __attribute__((ext_vector_type(2)));
__device__ __forceinline__ float bf_lo(unsigned w) { return __uint_as_float(w << 16); }
__device__ __forceinline__ float bf_hi(unsigned w) { return __uint_as_float(w & 0xffff0000u); }
__device__ __forceinline__ int fresh_lane() { int l; asm volatile("v_mbcnt_lo_u32_b32 %0, -1, 0\n\tv_mbcnt_hi_u32_b32 %0, -1, %0" : "=v"(l)); return l; }
#define PG8_DPP(x, ctrl) __int_as_float(__builtin_amdgcn_update_dpp(0, __float_as_int(x), (ctrl), 0xf, 0xf, true))
__device__ __forceinline__ float sum_fq(float s) {
    s += __int_as_float(__builtin_amdgcn_ds_swizzle(__float_as_int(s), (16 << 10) | 0x1f));
    auto rr = __builtin_amdgcn_permlane32_swap(__float_as_uint(s), __float_as_uint(s), false, false); return __uint_as_float(rr[0]) + __uint_as_float(rr[1]); }
__device__ __forceinline__ float max_row16(float s) {
    s = fmaxf(s, PG8_DPP(s, 0xB1)); s = fmaxf(s, PG8_DPP(s, 0x4E)); s = fmaxf(s, PG8_DPP(s, 0x141)); s = fmaxf(s, PG8_DPP(s, 0x140)); return s; }
__device__ __forceinline__ float sum_row8(float s) {
    s += PG8_DPP(s, 0xB1); s += PG8_DPP(s, 0x4E); s += PG8_DPP(s, 0x141); return s; }
__device__ __forceinline__ float sq8(const u32x4 w) {
    float s = 0.f;
    s += bf_lo(w.x) * bf_lo(w.x); s += bf_hi(w.x) * bf_hi(w.x); s += bf_lo(w.y) * bf_lo(w.y); s += bf_hi(w.y) * bf_hi(w.y);
    s += bf_lo(w.z) * bf_lo(w.z); s += bf_hi(w.z) * bf_hi(w.z); s += bf_lo(w.w) * bf_lo(w.w); s += bf_hi(w.w) * bf_hi(w.w);
    return s;
}
__device__ __forceinline__ u32x4 pack8(const f32x4 v0, const f32x4 v1) { u32x4 w; w.x = cvt_pk_bf16(v0[0], v0[1]); w.y = cvt_pk_bf16(v0[2], v0[3]); w.z = cvt_pk_bf16(v1[0], v1[1]); w.w = cvt_pk_bf16(v1[2], v1[3]); return w; }
__device__ __forceinline__ float row_rstd(const float* ssq, int row) {
    const f32x4* p = (const f32x4*)(ssq + (size_t)row * 16);
    const f32x4 a = p[0], b = p[1], c = p[2], d = p[3];
    const float s = ((a[0] + a[1]) + (a[2] + a[3])) + ((b[0] + b[1]) + (b[2] + b[3])) + ((c[0] + c[1]) + (c[2] + c[3])) + ((d[0] + d[1]) + (d[2] + d[3]));
    return __builtin_amdgcn_rsqf(s * (1.0f / 1024.0f) + 1e-6f);
}
__device__ __forceinline__ float sigmoid_f(float v) { return __builtin_amdgcn_rcpf(1.0f + __builtin_amdgcn_exp2f(-1.4426950408889634f * v)); }

__device__ __forceinline__ u32x4 swap_fr8(const u32x4 v) { u32x4 r;
    r.x = (unsigned)__builtin_amdgcn_update_dpp(0, (int)v.x, 0x128, 0xf, 0xf, false); r.y = (unsigned)__builtin_amdgcn_update_dpp(0, (int)v.y, 0x128, 0xf, 0xf, false);
    r.z = (unsigned)__builtin_amdgcn_update_dpp(0, (int)v.z, 0x128, 0xf, 0xf, false); r.w = (unsigned)__builtin_amdgcn_update_dpp(0, (int)v.w, 0x128, 0xf, 0xf, false); return r; }
__device__ __forceinline__ void full_line_pair(const u32x4 c0, const u32x4 c1, bool lo, u32x4& s0, u32x4& s1) {
    u32x4 snd; snd.x = lo ? c1.x : c0.x; snd.y = lo ? c1.y : c0.y; snd.z = lo ? c1.z : c0.z; snd.w = lo ? c1.w : c0.w;
    const u32x4 rcv = swap_fr8(snd);
    s0.x = lo ? c0.x : rcv.x; s0.y = lo ? c0.y : rcv.y; s0.z = lo ? c0.z : rcv.z; s0.w = lo ? c0.w : rcv.w;
    s1.x = lo ? rcv.x : c1.x; s1.y = lo ? rcv.y : c1.y; s1.z = lo ? rcv.z : c1.z; s1.w = lo ? rcv.w : c1.w;
}
struct EpiBf16Plain {
    static constexpr bool PERM = true, AFTER_DRAIN = false, BSPLIT = true;
    bf16_t* O; int ldc; int sc_lo, sc_hi; float scale; unsigned* KN; unsigned* QN; bf16_t* CU;
    __device__ __forceinline__ void operator()(const f32x4 (&acc)[2][2][4][2], const Unit& u, int wr, int wc, int fr, int fq) const {
        const bool lo = fr < 8;
        const int rowb = u.pm * BM + wr * 64 + (fr & 7), colb = u.pn * BM + wc * 64 + (lo ? 0 : 32) + 8 * fq;
        const float sc = (u.pn >= sc_lo && u.pn < sc_hi) ? scale : 1.f;
        const bool norms = KN != nullptr && u.pn >= 6 && u.pn < 10;
        if (CU != nullptr && u.pn >= 2 && u.pn < 6) {
            const int row0 = u.pm * BM + wr * 64 + fr, ch0 = (u.pn - 2) * HALF + wc * 32 + 8 * fq;
#pragma unroll
            for (int ai = 0; ai < 2; ++ai)
#pragma unroll
                for (int m = 0; m < 4; ++m) *(u32x4*)(CU + (size_t)(row0 + ai * HALF + m * 16) * 512 + ch0) = pack8(acc[ai][0][m][0] * acc[ai][1][m][0], acc[ai][0][m][1] * acc[ai][1][m][1]);
            return; }
        float qmx0 = 0.f, qmx1 = 0.f;
#pragma unroll
        for (int ai = 0; ai < 2; ++ai) { float mx0 = 0.f, mx1 = 0.f;
#pragma unroll
            for (int m = 0; m < 4; ++m) { bf16_t* rowp = O + (size_t)(rowb + ai * HALF + m * 16) * ldc + colb;
                const u32x4 c0 = pack8(acc[ai][0][m][0] * sc, acc[ai][0][m][1] * sc), c1 = pack8(acc[ai][1][m][0] * sc, acc[ai][1][m][1] * sc);
                if (norms) { const float a = sum_fq(sq8(c0)), b = sum_fq(sq8(c1)); mx0 = fmaxf(mx0, a); mx1 = fmaxf(mx1, b); }
                u32x4 s0, s1; full_line_pair(c0, c1, lo, s0, s1);
                *(u32x4*)rowp = s0; *(u32x4*)(rowp + (size_t)8 * ldc) = s1; }
            if (norms) {
                mx0 = max_row16(mx0); mx1 = max_row16(mx1);
                if (u.pn >= 8) { const int r64 = (u.pm * BM + ai * HALF + wr * 64) >> 6, bb = r64 >> 6, tile = r64 & 63, head = 4 * (u.pn & 1) + wc;
                    if (fr == 0 && fq == 0) { atomicMax(KN + ((size_t)(bb * 8 + head) * 64 + tile) * 2, __float_as_uint(mx0)); atomicMax(KN + ((size_t)(bb * 8 + head) * 64 + tile) * 2 + 1, __float_as_uint(mx1)); } }
                else { qmx0 = fmaxf(qmx0, mx0); qmx1 = fmaxf(qmx1, mx1); } } }
        if (norms && u.pn < 8 && fr == 0 && fq == 0) { const int bb = u.pm >> 4, qb = u.pm & 15, head = 4 * (u.pn & 1) + wc;
            atomicMax(QN + ((size_t)(bb * 8 + head) * 16 + qb) * 2, __float_as_uint(qmx0)); atomicMax(QN + ((size_t)(bb * 8 + head) * 16 + qb) * 2 + 1, __float_as_uint(qmx1)); }
    }
};
__device__ __forceinline__ void rows_rstd(const float* ssq, int row0, float (&rs)[2][4]) {
#pragma unroll
    for (int ai = 0; ai < 2; ++ai) { f32x4 t[4][4];
#pragma unroll
        for (int m = 0; m < 4; ++m) { const f32x4* p = (const f32x4*)(ssq + (size_t)(row0 + ai * HALF + m * 16) * 16);
#pragma unroll
            for (int q = 0; q < 4; ++q) t[m][q] = p[q]; }
#pragma unroll
        for (int m = 0; m < 4; ++m) { const f32x4 a = (t[m][0] + t[m][1]) + (t[m][2] + t[m][3]); rs[ai][m] = __builtin_amdgcn_rsqf(((a[0] + a[1]) + (a[2] + a[3])) * (1.0f / 1024.0f) + 1e-6f); } }
}
template <bool XF32> struct EpiRes {
    static constexpr bool PERM = true, AFTER_DRAIN = false, BSPLIT = false;
    const bf16_t* Hin; bf16_t* H; float* SSQ; const float* IRS;
    __device__ __forceinline__ void operator()(const f32x4 (&acc)[2][2][4][2], const Unit& u, int wr, int wc, int fr, int fq) const {
        const int row0 = u.pm * BM + wr * 64 + fr, col0 = u.pn * BM + wc * 32 + 8 * fq;
        u32x4 raw[8][2]; float irs[8];
#pragma unroll
        for (int it = 0; it < 8; ++it) { const int row = row0 + (it >> 2) * HALF + (it & 3) * 16; const size_t off = (size_t)row * 1024 + col0;
            irs[it] = XF32 ? IRS[row] : 1.f;
#pragma unroll
            for (int bj = 0; bj < 2; ++bj) raw[it][bj] = *(const u32x4*)(Hin + off + bj * HALF); }
#pragma unroll
        for (int it = 0; it < 8; ++it) { const int ai = it >> 2, m = it & 3; const int row = row0 + ai * HALF + m * 16; const size_t off = (size_t)row * 1024 + col0; float s = 0.f;
#pragma unroll
            for (int bj = 0; bj < 2; ++bj) { const u32x4 hw = raw[it][bj];
                f32x4 b0v = (f32x4){bf_lo(hw.x), bf_hi(hw.x), bf_lo(hw.y), bf_hi(hw.y)}, b1v = (f32x4){bf_lo(hw.z), bf_hi(hw.z), bf_lo(hw.w), bf_hi(hw.w)};
                if (XF32) { b0v = b0v * irs[it]; b1v = b1v * irs[it]; }
                const u32x4 w = pack8(acc[ai][bj][m][0] + b0v, acc[ai][bj][m][1] + b1v); *(u32x4*)(H + off + bj * HALF) = w; s += sq8(w); }
            s = sum_fq(s);
            if (fq == 0) SSQ[(size_t)row * 16 + u.pn * 4 + wc] = s; }
    }
};
struct EpiSwiglu {
    static constexpr bool PERM = true, AFTER_DRAIN = false, BSPLIT = false;
    bf16_t* ACT; const float* SSQ; const PG8_LAS float* RT;
    __device__ __forceinline__ void operator()(const f32x4 (&acc)[2][2][4][2], const Unit& u, int wr, int wc, int fr, int fq) const {
        const int row0 = u.pm * BM + wr * 64 + fr, col0 = u.pn * HALF + wc * 32 + 8 * fq;
        float rs[2][4];
        if (RT) { const PG8_LAS float* t = RT + ((u.pm >> 3) & 3) * 256 + wr * 64 + fr;
#pragma unroll
            for (int ai = 0; ai < 2; ++ai)
#pragma unroll
                for (int m = 0; m < 4; ++m) rs[ai][m] = t[ai * HALF + m * 16]; }
        else rows_rstd(SSQ, row0, rs);
#pragma unroll
        for (int ai = 0; ai < 2; ++ai)
#pragma unroll
            for (int m = 0; m < 4; ++m) { const int row = row0 + ai * HALF + m * 16; const float r = rs[ai][m];
                f32x4 o[2];
#pragma unroll
                for (int n = 0; n < 2; ++n) { const f32x4 g = acc[ai][0][m][n] * r, up = acc[ai][1][m][n] * r;
                    const f32x4 x = g * (-1.4426950408889634f); f32x4 d;
#pragma unroll
                    for (int i = 0; i < 4; ++i) d[i] = __builtin_amdgcn_exp2f(x[i]);
                    d = d + 1.0f;
#pragma unroll
                    for (int i = 0; i < 4; ++i) d[i] = __builtin_amdgcn_rcpf(d[i]);
                    o[n] = (g * d) * up; }
                *(u32x4*)(ACT + (size_t)row * 2816 + col0) = pack8(o[0], o[1]); }
    }
};
struct EpiPle {
    static constexpr bool PERM = true, AFTER_DRAIN = false, BSPLIT = false;
    const bf16_t* H2; const bf16_t* PROJ; const float* SSQ; const float* bg; bf16_t* OUT; const PG8_LAS float* RT;
    __device__ __forceinline__ void operator()(const f32x4 (&acc)[2][2][4][2], const Unit& u, int wr, int wc, int fr, int fq) const {
        const int row0 = u.pm * BM + wr * 64 + fr, col0 = u.pn * BM + wc * 32 + 8 * fq;
#pragma unroll
        for (int ai = 0; ai < 2; ++ai) {
            float rs[4];
            if (RT) { const PG8_LAS float* tt = RT + ((u.pm >> 3) & 3) * 256 + ai * HALF + wr * 64 + fr;
#pragma unroll
                for (int m = 0; m < 4; ++m) rs[m] = tt[m * 16]; }
            else { f32x4 t[4][4];
#pragma unroll
              for (int m = 0; m < 4; ++m) { const f32x4* p = (const f32x4*)(SSQ + (size_t)(row0 + ai * HALF + m * 16) * 16);
#pragma unroll
                  for (int q = 0; q < 4; ++q) t[m][q] = p[q]; }
#pragma unroll
              for (int m = 0; m < 4; ++m) { const f32x4 a = (t[m][0] + t[m][1]) + (t[m][2] + t[m][3]); rs[m] = __builtin_amdgcn_rsqf(((a[0] + a[1]) + (a[2] + a[3])) * (1.0f / 1024.0f) + 1e-6f); } }
            asm volatile("" ::: "memory");
            u32x4 hb[4][2], pb[4][2]; f32x4 bv[2][2];
#pragma unroll
            for (int m = 0; m < 4; ++m) { const size_t off = (size_t)(row0 + ai * HALF + m * 16) * 1024 + col0;
#pragma unroll
                for (int bj = 0; bj < 2; ++bj) { hb[m][bj] = *(const u32x4*)(H2 + off + bj * HALF); pb[m][bj] = *(const u32x4*)(PROJ + off + bj * HALF); } }
#pragma unroll
            for (int bj = 0; bj < 2; ++bj)
#pragma unroll
                for (int n = 0; n < 2; ++n) bv[bj][n] = *(const f32x4*)(bg + col0 + bj * HALF + 4 * n);
#pragma unroll
            for (int m = 0; m < 4; ++m) { const int row = row0 + ai * HALF + m * 16; const size_t off = (size_t)row * 1024 + col0; const float r = rs[m];
#pragma unroll
                for (int bj = 0; bj < 2; ++bj) { const u32x4 hw = hb[m][bj], pw = pb[m][bj];
                    const f32x4 h0 = (f32x4){bf_lo(hw.x), bf_hi(hw.x), bf_lo(hw.y), bf_hi(hw.y)}, h1 = (f32x4){bf_lo(hw.z), bf_hi(hw.z), bf_lo(hw.w), bf_hi(hw.w)};
                    const f32x4 p0 = (f32x4){bf_lo(pw.x), bf_hi(pw.x), bf_lo(pw.y), bf_hi(pw.y)}, p1 = (f32x4){bf_lo(pw.z), bf_hi(pw.z), bf_lo(pw.w), bf_hi(pw.w)};
                    const f32x4 a0 = acc[ai][bj][m][0] * r + bv[bj][0], a1 = acc[ai][bj][m][1] * r + bv[bj][1];
                    f32x4 d0 = a0 * (-1.4426950408889634f), d1 = a1 * (-1.4426950408889634f);
#pragma unroll
                    for (int i2 = 0; i2 < 4; ++i2) { d0[i2] = __builtin_amdgcn_exp2f(d0[i2]); d1[i2] = __builtin_amdgcn_exp2f(d1[i2]); }
                    d0 = d0 + 1.0f; d1 = d1 + 1.0f;
#pragma unroll
                    for (int i2 = 0; i2 < 4; ++i2) { d0[i2] = __builtin_amdgcn_rcpf(d0[i2]); d1[i2] = __builtin_amdgcn_rcpf(d1[i2]); }
                    *(u32x4*)(OUT + off + bj * HALF) = pack8(h0 + d0 * p0, h1 + d1 * p1); } }
            asm volatile("" ::: "memory"); }
    }
};

template <class Epi, class Sched, bool ALIGN_EPI = false, bool SP2 = false>
__device__ __forceinline__ void gemm_phase(PG8_LAS unsigned char* lds, const Gemm g, const Sched& S, const Epi& E, const int wave) {
    int tid_ = wave * 64 + fresh_lane(); asm volatile("" : "+v"(tid_));
    const int tid = tid_, wid = __builtin_amdgcn_readfirstlane(tid >> 6), lane = tid & 63, wr = wid >> 2, wc = wid & 3, fr = lane & 15, fq = lane >> 4;
    const int K = g.K, nt = K / BK;
    unsigned voffA[2], voffB[2];
#pragma unroll
    for (int i = 0; i < 2; ++i) { int R, C; stage_rc(tid * 16 + i * 8192, R, C); const int Rb = Epi::BSPLIT ? (64 * (R >> 5) + perm32(R & 31)) : (Epi::PERM ? ((R & ~31) + perm32(R & 31)) : R);
        voffA[i] = (unsigned)(R * K + C) * 2u; voffB[i] = (unsigned)(Rb * K + C) * 2u; }
    const size_t kstep = (size_t)(BK * 2);
    const size_t hstep = (size_t)HALF * K * 2;
    const size_t tstep = 2 * hstep;
    const size_t hstepB = Epi::BSPLIT ? (size_t)32 * K * 2 : hstep;
    const unsigned ldsw = (unsigned)wid * 1024u;
    const int aoff = lds_byte(wr * 64 + fr, fq * 8), boff = lds_byte(wc * 32 + fr, fq * 8);
#define PG8_SA(b, h) (((b) * 2 + (h)) * HTB)
#define PG8_SB(b, h) ((4 + (b) * 2 + (h)) * HTB)
#define PG8_STAGE(bufoff, gbase, voff) do { _Pragma("unroll") for (int _i = 0; _i < 2; ++_i) \
        __builtin_amdgcn_global_load_lds((const unsigned*)((const char*)(gbase) + (voff)[_i]), (PG8_LAS unsigned*)(lds + (bufoff) + ldsw + _i * 8192), 16, 0, 0); } while (0)
#define PG8_LDA(dst, b, h) do { _Pragma("unroll") for (int m = 0; m < 4; ++m) _Pragma("unroll") for (int k = 0; k < 2; ++k) dst[m][k] = *(const PG8_LAS bf16x8*)(lds + PG8_SA(b, h) + aoff + m * 2048 + k * 1024); } while (0)
#define PG8_LDB(dst, b, h) do { _Pragma("unroll") for (int n = 0; n < 2; ++n) _Pragma("unroll") for (int k = 0; k < 2; ++k) dst[n][k] = *(const PG8_LAS bf16x8*)(lds + PG8_SB(b, h) + boff + n * 2048 + k * 1024); } while (0)
#define PG8_MMA(ai, bj, At, Bt) do { __builtin_amdgcn_s_setprio(1); _Pragma("unroll") for (int m = 0; m < 4; ++m) _Pragma("unroll") for (int n = 0; n < 2; ++n) _Pragma("unroll") for (int k = 0; k < 2; ++k) \
        acc[ai][bj][m][n] = __builtin_amdgcn_mfma_f32_16x16x32_bf16(Bt[n][k], At[m][k], acc[ai][bj][m][n], 0, 0, 0); __builtin_amdgcn_s_setprio(0); } while (0)
#define PG8_WAIT_V(n) asm volatile("s_waitcnt vmcnt(" #n ")" ::: "memory")
#define PG8_WAIT_L(n) asm volatile("s_waitcnt lgkmcnt(" #n ")" ::: "memory")
#define PG8_BAR __builtin_amdgcn_s_barrier()
#define PG8_SCHED __builtin_amdgcn_sched_barrier(0)
    Unit cur, nxt; int ui = 0;
    if (!S.next(0, cur)) return;
    f32x4 acc[2][2][4][2];
#pragma unroll
    for (int a = 0; a < 2; ++a)
#pragma unroll
        for (int b = 0; b < 2; ++b)
#pragma unroll
            for (int m = 0; m < 4; ++m)
#pragma unroll
                for (int n = 0; n < 2; ++n) acc[a][b][m][n] = (f32x4){0.f, 0.f, 0.f, 0.f};
    bf16x8 At[4][2], B0[2][2], B1[2][2];
    const char* cA = (const char*)g.A + (size_t)cur.pm * tstep; const char* cB = (const char*)g.Bt + (size_t)cur.pn * tstep;
    S.a_ready(cur);
    if constexpr (SP2) {
        PG8_STAGE(PG8_SB(0, 0), cB, voffB); PG8_STAGE(PG8_SB(0, 1), cB + hstepB, voffB); PG8_STAGE(PG8_SA(0, 0), cA, voffA); PG8_STAGE(PG8_SA(0, 1), cA + hstep, voffA);
        if (wr == 1) PG8_BAR;
        PG8_WAIT_V(2); PG8_BAR;
        PG8_STAGE(PG8_SB(1, 0), cB + kstep, voffB); PG8_STAGE(PG8_SA(1, 0), cA + kstep, voffA); PG8_STAGE(PG8_SB(1, 1), cB + hstepB + kstep, voffB);
        PG8_WAIT_V(6); PG8_BAR;
    } else {
        PG8_STAGE(PG8_SB(0, 0), cB, voffB); PG8_STAGE(PG8_SA(0, 0), cA, voffA); PG8_STAGE(PG8_SB(0, 1), cB + hstepB, voffB); PG8_STAGE(PG8_SA(0, 1), cA + hstep, voffA);
        if (wr == 1) PG8_BAR;
        PG8_WAIT_V(4); PG8_BAR;
        PG8_STAGE(PG8_SB(1, 0), cB + kstep, voffB); PG8_STAGE(PG8_SA(1, 0), cA + kstep, voffA); PG8_STAGE(PG8_SB(1, 1), cB + hstepB + kstep, voffB);
        PG8_WAIT_V(6); PG8_BAR;
    }
    for (;;) {
        const bool has_next = S.next(ui + 1, nxt);
        const char* nA = has_next ? (const char*)g.A + (size_t)nxt.pm * tstep : cA; const char* nB = has_next ? (const char*)g.Bt + (size_t)nxt.pn * tstep : cB;
        for (int t = 0; t < nt; t += 2) {
            const bool last = (t == nt - 2);
            const char* a1 = cA + (size_t)(t + 1) * kstep;
            const char* a2 = last ? nA : cA + (size_t)(t + 2) * kstep; const char* b2 = last ? nB : cB + (size_t)(t + 2) * kstep;
            const char* a3 = a2 + kstep; const char* b3 = b2 + kstep;
            if (last && has_next) S.a_ready(nxt);
            if constexpr (SP2) {
            PG8_LDB(B0, 0, 0); PG8_LDB(B1, 0, 1); PG8_SCHED; PG8_LDA(At, 0, 0); PG8_STAGE(PG8_SA(1, 1), a1 + hstep, voffA);
            PG8_WAIT_V(8); PG8_WAIT_L(0); PG8_BAR; PG8_MMA(0, 0, At, B0); PG8_MMA(0, 1, At, B1); PG8_BAR; PG8_SCHED;
            PG8_LDA(At, 0, 1); PG8_STAGE(PG8_SB(0, 0), b2, voffB); PG8_STAGE(PG8_SB(0, 1), b2 + hstepB, voffB); PG8_STAGE(PG8_SA(0, 0), a2, voffA);
            PG8_WAIT_V(8); PG8_WAIT_L(0); PG8_BAR; PG8_MMA(1, 0, At, B0); PG8_MMA(1, 1, At, B1); PG8_BAR; PG8_SCHED;
            PG8_LDB(B0, 1, 0); PG8_LDB(B1, 1, 1); PG8_SCHED; PG8_LDA(At, 1, 0); PG8_STAGE(PG8_SA(0, 1), a2 + hstep, voffA);
            PG8_WAIT_V(8); PG8_WAIT_L(0); PG8_BAR; PG8_MMA(0, 0, At, B0); PG8_MMA(0, 1, At, B1); PG8_BAR; PG8_SCHED;
            PG8_LDA(At, 1, 1); PG8_STAGE(PG8_SB(1, 0), b3, voffB); PG8_STAGE(PG8_SB(1, 1), b3 + hstepB, voffB); PG8_STAGE(PG8_SA(1, 0), a3, voffA);
            PG8_WAIT_V(8); PG8_WAIT_L(0); PG8_BAR; PG8_MMA(1, 0, At, B0); PG8_MMA(1, 1, At, B1); PG8_BAR; PG8_SCHED;
            } else {
            PG8_LDB(B0, 0, 0); PG8_SCHED; PG8_LDA(At, 0, 0); PG8_STAGE(PG8_SA(1, 1), a1 + hstep, voffA);
            PG8_WAIT_L(8); PG8_BAR; PG8_WAIT_L(0); PG8_MMA(0, 0, At, B0); PG8_BAR; PG8_SCHED;
            PG8_LDB(B1, 0, 1); PG8_STAGE(PG8_SB(0, 0), b2, voffB);
            PG8_BAR; PG8_WAIT_L(0); PG8_MMA(0, 1, At, B1); PG8_BAR;
            PG8_LDA(At, 0, 1); PG8_STAGE(PG8_SA(0, 0), a2, voffA);
            PG8_BAR; PG8_WAIT_L(0); PG8_MMA(1, 0, At, B0); PG8_BAR; PG8_SCHED;
            PG8_STAGE(PG8_SB(0, 1), b2 + hstepB, voffB);
            PG8_WAIT_V(6); PG8_BAR; PG8_MMA(1, 1, At, B1); PG8_BAR;
            PG8_LDB(B0, 1, 0); PG8_SCHED; PG8_LDA(At, 1, 0); PG8_STAGE(PG8_SA(0, 1), a2 + hstep, voffA);
            PG8_WAIT_L(8); PG8_BAR; PG8_WAIT_L(0); PG8_MMA(0, 0, At, B0); PG8_BAR; PG8_SCHED;
            PG8_LDB(B1, 1, 1); PG8_STAGE(PG8_SB(1, 0), b3, voffB);
            PG8_BAR; PG8_WAIT_L(0); PG8_MMA(0, 1, At, B1); PG8_BAR;
            PG8_LDA(At, 1, 1); PG8_STAGE(PG8_SA(1, 0), a3, voffA);
            PG8_BAR; PG8_WAIT_L(0); PG8_MMA(1, 0, At, B0); PG8_BAR; PG8_SCHED;
            PG8_STAGE(PG8_SB(1, 1), b3 + hstepB, voffB);
            PG8_WAIT_V(6); PG8_BAR; PG8_MMA(1, 1, At, B1); PG8_BAR;
            }
        }
        if constexpr (ALIGN_EPI) { if (wr == 0) PG8_BAR; }
        if constexpr (!Epi::AFTER_DRAIN) { E(acc, cur, wr, wc, fr, fq); S.done(cur); }
        if (!has_next) break;
#pragma unroll
        for (int a = 0; a < 2; ++a)
#pragma unroll
            for (int b = 0; b < 2; ++b)
#pragma unroll
                for (int m = 0; m < 4; ++m)
#pragma unroll
                    for (int n = 0; n < 2; ++n) acc[a][b][m][n] = (f32x4){0.f, 0.f, 0.f, 0.f};
        cur = nxt; cA = nA; cB = nB; ++ui;
        if constexpr (ALIGN_EPI) { if (wr == 1) PG8_BAR; }
    }
    PG8_WAIT_V(0);
    if constexpr (!ALIGN_EPI) { if (wr == 0) PG8_BAR; }
    PG8_BAR;
    if constexpr (Epi::AFTER_DRAIN) { E.fused(acc, cur, wr, wc, fr, fq, lds, wid, lane); S.done(cur); }
#undef PG8_SA
#undef PG8_SB
#undef PG8_STAGE
#undef PG8_LDA
#undef PG8_LDB
#undef PG8_MMA
#undef PG8_WAIT_V
#undef PG8_WAIT_L
#undef PG8_BAR
#undef PG8_SCHED
}
}

#ifndef PG8_SP2
#define PG8_SP2 true
#endif
#ifndef PG8_ALIGN
#define PG8_ALIGN true
#endif
namespace attn_body {
using bf16=__hip_bfloat16;
using bf16x8=__attribute__((ext_vector_type(8)))short;
using s16x4=__attribute__((ext_vector_type(4)))short;
using f32x16=__attribute__((ext_vector_type(16)))float;
using f32x4a=__attribute__((ext_vector_type(4)))float;
using u32x4=__attribute__((ext_vector_type(4)))unsigned;
constexpr int NHEAD=8,SEQL=4096,D=64,DMI=3072,DMO=1024;
constexpr int NW=8,QBLK=32,QB=QBLK*NW,KVBLK=64,NQB=SEQL/QB;
__device__ __forceinline__ int crow(int r,int hi){return (r&3)+8*(r>>2)+4*hi;}
#define SBAR() __builtin_amdgcn_sched_barrier(0)
__device__ __forceinline__ void cmask(f32x16&p0,f32x16&p1,int jb,int qrel,int hi){
  const float NEG=-INFINITY; int kb=64*jb+4*hi; asm volatile("":"+v"(kb));
  #pragma unroll
  for(int r=0;r<16;++r){int kv=kb+(r&3)+8*(r>>2); if(kv>qrel)p0[r]=NEG; if(kv+32>qrel)p1[r]=NEG;}
}

constexpr int NSLOT=3, SLOTB=8192;
constexpr int LDS_K=0, LDS_V=NSLOT*SLOTB, LDS_WS=2*NSLOT*SLOTB, LDS_OST=LDS_WS+NW*64*4, LDS_CLT=LDS_OST+NW*4096, LDS_BYTES=LDS_CLT+SEQL*4;
__device__ __forceinline__ void glds16(const void*gsrc,unsigned lds_dst){unsigned keep;
  asm volatile("s_mov_b32 %0, m0\n\ts_mov_b32 m0, %2\n\ts_nop 0\n\tglobal_load_lds_dwordx4 %1, off\n\ts_mov_b32 m0, %0":"=&s"(keep):"v"(gsrc),"s"(lds_dst):"memory");}
__device__ __forceinline__ float max3f(float a,float b,float c){float r;asm("v_max3_f32 %0, %1, %2, %3":"=v"(r):"v"(a),"v"(b),"v"(c));return r;}
__device__ __forceinline__ float max2f(float a,float b){float r;asm("v_max_f32_e32 %0, %1, %2":"=v"(r):"v"(a),"v"(b));return r;}
typedef float f32x2_t __attribute__((ext_vector_type(2))); typedef __bf16 bf16x2_t __attribute__((ext_vector_type(2)));
__device__ __forceinline__ unsigned cvtpk_s(float lo,float hi){f32x2_t v={lo,hi};bf16x2_t b=__builtin_convertvector(v,bf16x2_t);return __builtin_bit_cast(unsigned,b);}
#define WAIT_BAR(N) asm volatile("s_waitcnt vmcnt(" #N ") lgkmcnt(0)\n\ts_barrier":::"memory")
template<int MASK> __device__ __forceinline__ float xor_lane(float v){
  if constexpr(MASK==32){ auto rr=__builtin_amdgcn_permlane32_swap(__float_as_uint(v),__float_as_uint(v),false,false); return __uint_as_float((pg8::fresh_lane()&32)?rr[0]:rr[1]); }
  else return __int_as_float(__builtin_amdgcn_ds_swizzle(__float_as_int(v),(MASK<<10)|0x1f)); }

__device__ __forceinline__ void qkt(f32x16&p0,f32x16&p1,const char*Kslot,const bf16x8*qr,int r32,int hi){
  const char*kb=Kslot+hi*1024+r32*16;
  #pragma unroll
  for(int d0=0;d0<4;++d0){
    const bf16x8 b0=*reinterpret_cast<const bf16x8*>(kb+d0*2048);
    const bf16x8 b1=*reinterpret_cast<const bf16x8*>(kb+d0*2048+512);
    p0=__builtin_amdgcn_mfma_f32_32x32x16_bf16(b0,qr[d0],p0,0,0,0);p1=__builtin_amdgcn_mfma_f32_32x32x16_bf16(b1,qr[d0],p1,0,0,0);}
}
typedef __attribute__((address_space(3))) const char* lds_cptr;
typedef short v4i16_t __attribute__((ext_vector_type(4)));
__device__ __forceinline__ void kload8(bf16x8*kf,lds_cptr kp){
  kf[0]=*(const __attribute__((address_space(3))) bf16x8*)(kp);      kf[1]=*(const __attribute__((address_space(3))) bf16x8*)(kp+512);
  kf[2]=*(const __attribute__((address_space(3))) bf16x8*)(kp+2048); kf[3]=*(const __attribute__((address_space(3))) bf16x8*)(kp+2560);
  kf[4]=*(const __attribute__((address_space(3))) bf16x8*)(kp+4096); kf[5]=*(const __attribute__((address_space(3))) bf16x8*)(kp+4608);
  kf[6]=*(const __attribute__((address_space(3))) bf16x8*)(kp+6144); kf[7]=*(const __attribute__((address_space(3))) bf16x8*)(kp+6656);
}
__device__ __forceinline__ void kload2(bf16x8*kf,lds_cptr kp,int j){ kf[2*j]=*(const __attribute__((address_space(3))) bf16x8*)(kp+j*2048); kf[2*j+1]=*(const __attribute__((address_space(3))) bf16x8*)(kp+j*2048+512); }
__device__ __forceinline__ s16x4 vtr(lds_cptr p){ return __builtin_bit_cast(s16x4,__builtin_amdgcn_ds_read_tr16_b64_v4i16((__attribute__((address_space(3))) v4i16_t*)p)); }
__device__ __forceinline__ float rowmax(const f32x16&p0,const f32x16&p1){
  float a=max3f(p0[0],p0[1],p1[0]),b=max3f(p0[2],p0[3],p1[1]);a=max3f(a,p1[2],p1[3]);
  #pragma unroll
  for(int r=4;r<16;r+=4){a=max3f(a,p0[r],p0[r+1]);b=max3f(b,p0[r+2],p0[r+3]);a=max3f(a,p1[r],p1[r+1]);b=max3f(b,p1[r+2],p1[r+3]);}
  const float m=max2f(a,b);
  auto rr=__builtin_amdgcn_permlane32_swap(__float_as_uint(m),__float_as_uint(m),false,false);
  return max2f(__uint_as_float(rr[0]),__uint_as_float(rr[1]));
}
__device__ __forceinline__ void pv(f32x16*o,int vb,bf16x8 pa0,bf16x8 pa1,bf16x8 pa2,bf16x8 pa3){
  #pragma unroll
  for(int d0=0;d0<2;++d0){s16x4 lo[4],hi[4];
    #pragma unroll
    for(int ks=0;ks<4;++ks){
      asm volatile("ds_read_b64_tr_b16 %0,%1 offset:%c2":"=&v"(lo[ks]):"v"(vb),"i"(d0*4096+ks*1024):"memory");
      asm volatile("ds_read_b64_tr_b16 %0,%1 offset:%c2":"=&v"(hi[ks]):"v"(vb),"i"(d0*4096+ks*1024+512):"memory");}
    asm volatile("s_waitcnt lgkmcnt(0)":::"memory");SBAR();
    #define PK(k) (bf16x8){lo[k][0],lo[k][1],lo[k][2],lo[k][3],hi[k][0],hi[k][1],hi[k][2],hi[k][3]}
    o[d0]=__builtin_amdgcn_mfma_f32_32x32x16_bf16(pa0,PK(0),o[d0],0,0,0);
    o[d0]=__builtin_amdgcn_mfma_f32_32x32x16_bf16(pa1,PK(1),o[d0],0,0,0);
    o[d0]=__builtin_amdgcn_mfma_f32_32x32x16_bf16(pa2,PK(2),o[d0],0,0,0);
    o[d0]=__builtin_amdgcn_mfma_f32_32x32x16_bf16(pa3,PK(3),o[d0],0,0,0);
    #undef PK
  }
}

__device__ __forceinline__ int attn_skip_t0(int qb,const float*CLrow,const float*KNrow,const float*QNp,int lane){
  const int q0=qb*QB,NT0=(q0+QB)/KVBLK; const float ql=sqrtf(QNp[0])*1.004f,qh=sqrtf(QNp[1])*1.004f; float bnd=0.f,clend=0.f;
  if(lane<NT0){ bnd=ql*sqrtf(KNrow[2*lane])*1.004f+qh*sqrtf(KNrow[2*lane+1])*1.004f; clend=CLrow[64*lane+63]; }
  const float clq0=CLrow[q0]; float bd=(lane>=NT0-4&&lane<NT0)?bnd:0.f;
  bd=__builtin_fmaxf(bd,xor_lane<1>(bd)); bd=__builtin_fmaxf(bd,xor_lane<2>(bd)); bd=__builtin_fmaxf(bd,xor_lane<4>(bd)); bd=__builtin_fmaxf(bd,xor_lane<8>(bd)); bd=__builtin_fmaxf(bd,xor_lane<16>(bd));
  { auto rr=__builtin_amdgcn_permlane32_swap(__float_as_uint(bd),__float_as_uint(bd),false,false); bd=__builtin_fmaxf(__uint_as_float(rr[0]),__uint_as_float(rr[1])); }
  const bool skip=(lane<NT0-4)&&(bnd+(clq0-clend)<-bd-32.0f);
  const unsigned long long inv=~__ballot(skip); const int run=inv?__builtin_ctzll(inv):64;
  const int t0=__builtin_amdgcn_readfirstlane(((run<NT0-4)?run:(NT0-4))&~1);
  float bm=(lane>=t0&&lane<NT0)?bnd:0.f;
  bm=__builtin_fmaxf(bm,xor_lane<1>(bm)); bm=__builtin_fmaxf(bm,xor_lane<2>(bm)); bm=__builtin_fmaxf(bm,xor_lane<4>(bm)); bm=__builtin_fmaxf(bm,xor_lane<8>(bm)); bm=__builtin_fmaxf(bm,xor_lane<16>(bm));
  { auto rr=__builtin_amdgcn_permlane32_swap(__float_as_uint(bm),__float_as_uint(bm),false,false); bm=__builtin_fmaxf(__uint_as_float(rr[0]),__uint_as_float(rr[1])); }
  const int bounded=(bm<64.0f)?1:0;
  return t0|(__builtin_amdgcn_readfirstlane(bounded)<<16);
}
#ifndef ATTN_STORE16
#define ATTN_STORE16(p,v) (*(u32x4*)(p)=(v))
#endif
template<int THRL,bool NOMAX> __device__ __forceinline__ void attn_unit(int b,int h,int qb,const bf16*Q,const bf16*__restrict__ K,const bf16*__restrict__ V,bf16*O,const float*CLrow,const float*gout,const int t0,char*shm,const int wave){
  int tid_=wave*64+pg8::fresh_lane(); asm volatile("":"+v"(tid_));
  const int tid=tid_,lane=tid&63,r32=lane&31,hi=lane>>5; const int wid=__builtin_amdgcn_readfirstlane(tid>>6);
  const long rowbase=(long)b*SEQL; const int q0=qb*QB;
  const bf16*Qw=Q+(rowbase+q0+wid*QBLK)*DMI+h*D;
  const bf16*Kh=K+rowbase*DMI+h*D,*Vh=V+rowbase*DMI+h*D;
  const unsigned lds0=(unsigned)(uintptr_t)shm;
  float*wsf=(float*)(shm+LDS_WS)+wid*64;
  const lds_cptr shm3=(lds_cptr)shm;
  { const float*csrc=CLrow+wid*256+lane*4; const unsigned cdst=lds0+LDS_CLT+wid*1024;
    glds16(csrc,(unsigned)__builtin_amdgcn_readfirstlane(cdst)); glds16(csrc+2048,(unsigned)__builtin_amdgcn_readfirstlane(cdst+8192)); }
  const bf16*ksrc=Kh+(long)t0*KVBLK*DMI+(long)lane*DMI+wid*8;
  const bf16*vsrc=Vh+(long)t0*KVBLK*DMI+(long)(16*(wid&3)+(lane>>2))*DMI+(wid>>2)*32+(lane&3)*8;
  const unsigned kdst=lds0+LDS_K+wid*1024, vdst=lds0+LDS_V+wid*1024;
  #define DMA_K(t,slot) glds16(ksrc+(long)(t)*KVBLK*DMI,(unsigned)__builtin_amdgcn_readfirstlane(kdst+(slot)))
  #define DMA_V(t,slot) glds16(vsrc+(long)(t)*KVBLK*DMI,(unsigned)__builtin_amdgcn_readfirstlane(vdst+(slot)))
  const int vb0=(int)(lds0+LDS_V)+((lane>>4)&1)*32+(lane&3)*8+(4*hi+((lane&15)>>2))*64;
  const char*Kbase=shm+LDS_K; bf16x8 kf[8];
  const lds_cptr kp0=shm3+LDS_K+hi*1024+r32*16; const lds_cptr vp0=shm3+LDS_V+((lane>>4)&1)*32+(lane&3)*8+(4*hi+((lane&15)>>2))*64;
  const lds_cptr clp0=shm3+LDS_CLT+hi*16+t0*256;
  const int NT=(q0+QB)/KVBLK-t0;
  DMA_K(0,0);DMA_V(0,0);DMA_K(1,SLOTB);
  bf16x8 qr[4];
  #pragma unroll
  for(int d0=0;d0<4;++d0)qr[d0]=*reinterpret_cast<const bf16x8*>(&Qw[(long)r32*DMI+d0*16+hi*8]);
  float mhat=0.f,l_reg=0.f;f32x16 o[2];o[0]=f32x16{};o[1]=f32x16{};
  const int qrel=wid*QBLK+r32;
  #define CMASK(P0,P1,t) do{int jb_=(t)-(NT-4); if(jb_>=0)cmask(P0,P1,jb_,qrel,hi);}while(0)
  #define CQ(C,g_,off_) do{ const f32x4a a_=*(const __attribute__((address_space(3))) f32x4a*)(cp_+32*(g_)+(off_)); \
      C[4*(g_)]=base_-a_[0]; C[4*(g_)+1]=base_-a_[1]; C[4*(g_)+2]=base_-a_[2]; C[4*(g_)+3]=base_-a_[3]; }while(0)
  #define CINIT(C0,C1,t) do{ const lds_cptr cp_=clp0+(t)*256; const float base_=cql-mhat; \
    CQ(C0,0,0); CQ(C0,1,0); SBAR(); CQ(C0,2,0); CQ(C0,3,0); SBAR(); CQ(C1,0,128); CQ(C1,1,128); SBAR(); CQ(C1,2,128); CQ(C1,3,128); }while(0)
  bool resc=false;
  #define RESC() do{ if(resc){ asm volatile("s_waitcnt lgkmcnt(0)":::"memory"); \
      _Pragma("unroll") for(int d_=0;d_<2;++d_) _Pragma("unroll") for(int r=0;r<16;++r)o[d_][r]*=wsf[crow(r,hi)]; } }while(0)
  f32x16 pA0,pA1,pB0,pB1;
  int sl_prev=0,sl_cur=0,sl_next=SLOTB;
  #define ROT() do{sl_prev=sl_cur;sl_cur=sl_next;sl_next=(sl_next==(NSLOT-1)*SLOTB)?0:sl_next+SLOTB;}while(0)
  DMA_K(2,2*SLOTB);
  WAIT_BAR(3);
  const float cql=*(const __attribute__((address_space(3))) float*)(shm3+LDS_CLT+(q0+qrel)*4);
  CINIT(pA0,pA1,0);
  qkt(pA0,pA1,Kbase,qr,r32,hi);CMASK(pA0,pA1,0);
  { if constexpr(!NOMAX){ const float rm=rowmax(pA0,pA1);
    if(__any(rm>(float)THRL)){ const float dl=__builtin_fmaxf(rm,0.f); mhat+=dl;
      _Pragma("unroll") for(int r=0;r<16;++r){pA0[r]-=dl;pA1[r]-=dl;} } }
    _Pragma("unroll") for(int r=0;r<16;++r){pA0[r]=__builtin_amdgcn_exp2f(pA0[r]);pA1[r]=__builtin_amdgcn_exp2f(pA1[r]);} }
  WAIT_BAR(0);
  DMA_K(3,0);DMA_V(1,SLOTB);
  ROT();
  kload8(kf,kp0+sl_cur);
  CINIT(pB0,pB1,1);
  WAIT_BAR(2);
  s16x4 vlo[4],vhi[4]; u32x4 pw0,pw1,pw2,pw3;
  #define PKW(P,B) cvtpk_s(P[B],P[B+1])
  #define PAF(k) __builtin_bit_cast(bf16x8,pw##k)
  #define VFR(i) (bf16x8){vlo[i][0],vlo[i][1],vlo[i][2],vlo[i][3],vhi[i][0],vhi[i][1],vhi[i][2],vhi[i][3]}
  #define PIN(x) asm volatile("":"+v"(x))
  #define MX3(a,b,c) __builtin_fmaxf(__builtin_fmaxf((a),(b)),(c))
  #define GAPA(MF,A0,A1,A2,A3,W0,W1,PW) do{ MF; sacc+=A0; sacc+=A1; sacc+=A2; sacc+=A3; PIN(sacc); W0; W1; PIN(PW); SBAR(); }while(0)
  #define EX(v) __builtin_amdgcn_exp2f(v)
  #define GAPB(MF,X,B) do{ MF; X[B]=EX(X[B]); X[B+1]=EX(X[B+1]); X[B+2]=EX(X[B+2]); X[B+3]=EX(X[B+3]); PIN(X); SBAR(); }while(0)
  #define VRD(s_,i) do{ vlo[s_]=vtr(vp_+(((i)>>2)*4096+((i)&3)*1024)); vhi[s_]=vtr(vp_+(((i)>>2)*4096+((i)&3)*1024+512)); }while(0)
  #define KRD(G,j) do{ if(G){ kload2(kf,kp0+sl_next,j); SBAR(); } }while(0)
  #define CLD(dst,k) do{ dst=*(const __attribute__((address_space(3))) f32x4a*)(cpn_+32*((k)&3)+128*((k)>>2)); }while(0)
  #define CSUB(P,g,a) do{ P[4*(g)]=basen_-a[0]; P[4*(g)+1]=basen_-a[1]; P[4*(g)+2]=basen_-a[2]; P[4*(g)+3]=basen_-a[3]; }while(0)
  #define STEP(C0,C1,P0,P1,t,GK,GV,GL) do{ SBAR(); \
    const lds_cptr vp_=vp0+sl_prev; \
    float sacc=(P0[0]+P0[1]); \
    GAPA(C0=__builtin_amdgcn_mfma_f32_32x32x16_bf16(kf[0],qr[0],C0,0,0,0), P0[2],P0[3],P0[4],P0[5],     pw0[0]=PKW(P0,0), pw0[1]=PKW(P0,2), pw0); \
    GAPA(C1=__builtin_amdgcn_mfma_f32_32x32x16_bf16(kf[1],qr[0],C1,0,0,0), P0[6],P0[7],P0[8],P0[9],     pw0[2]=PKW(P0,4), pw0[3]=PKW(P0,6), pw0); \
    GAPA(C0=__builtin_amdgcn_mfma_f32_32x32x16_bf16(kf[2],qr[1],C0,0,0,0),   P0[10],P0[11],P0[12],P0[13], pw1[0]=PKW(P0,8), pw1[1]=PKW(P0,10), pw1); \
    GAPA(C1=__builtin_amdgcn_mfma_f32_32x32x16_bf16(kf[3],qr[1],C1,0,0,0),   P0[14],P0[15],P1[0],P1[1],   pw1[2]=PKW(P0,12),pw1[3]=PKW(P0,14), pw1); \
    VRD(0,0); SBAR(); GAPA(C0=__builtin_amdgcn_mfma_f32_32x32x16_bf16(kf[4],qr[2],C0,0,0,0),   P1[2],P1[3],P1[4],P1[5],     pw2[0]=PKW(P1,0), pw2[1]=PKW(P1,2), pw2); \
    VRD(1,4); SBAR(); GAPA(C1=__builtin_amdgcn_mfma_f32_32x32x16_bf16(kf[5],qr[2],C1,0,0,0),   P1[6],P1[7],P1[8],P1[9],     pw2[2]=PKW(P1,4), pw2[3]=PKW(P1,6), pw2); \
    VRD(2,1); SBAR(); GAPA(C0=__builtin_amdgcn_mfma_f32_32x32x16_bf16(kf[6],qr[3],C0,0,0,0),   P1[10],P1[11],P1[12],P1[13], pw3[0]=PKW(P1,8), pw3[1]=PKW(P1,10), pw3); \
    VRD(3,5); SBAR(); GAPA(C1=__builtin_amdgcn_mfma_f32_32x32x16_bf16(kf[7],qr[3],C1,0,0,0),   P1[14],P1[15],0.f,0.f,       pw3[2]=PKW(P1,12),pw3[3]=PKW(P1,14), pw3); \
    l_reg+=sacc; \
    if(GK){DMA_K((t)+3,sl_cur);} if(GV){DMA_V((t)+1,sl_next);} \
    CMASK(C0,C1,t); \
    if constexpr(!NOMAX){ float a=MX3(C0[0],C0[1],C1[0]),b=MX3(C0[2],C0[3],C1[1]); a=MX3(a,C1[2],C1[3]); \
      _Pragma("unroll") for(int r=4;r<16;r+=4){a=MX3(a,C0[r],C0[r+1]);b=MX3(b,C0[r+2],C0[r+3]);a=MX3(a,C1[r],C1[r+1]);b=MX3(b,C1[r+2],C1[r+3]);} \
      float rm=__builtin_fmaxf(a,b); { auto rr=__builtin_amdgcn_permlane32_swap(__float_as_uint(rm),__float_as_uint(rm),false,false); rm=__builtin_fmaxf(__uint_as_float(rr[0]),__uint_as_float(rr[1])); } \
      resc=false; \
      if(__builtin_expect(__any(rm>(float)THRL),0)){ const float dl=__builtin_fmaxf(rm,0.f); mhat+=dl; \
        _Pragma("unroll") for(int r=0;r<16;++r){C0[r]-=dl;C1[r]-=dl;} \
        const float f=__builtin_amdgcn_exp2f(-dl); l_reg*=f; if(hi==0)wsf[r32]=f; resc=true; } } \
    const lds_cptr cpn_=clp0+((t)+1)*256; const float basen_=cql-mhat; f32x4a ca_; \
    SBAR(); \
    CLD(ca_,0); GAPB(o[0]=__builtin_amdgcn_mfma_f32_32x32x16_bf16(PAF(0),VFR(0),o[0],0,0,0), C0,0); \
    VRD(0,2); CSUB(P0,0,ca_); CLD(ca_,1); GAPB(o[1]=__builtin_amdgcn_mfma_f32_32x32x16_bf16(PAF(0),VFR(1),o[1],0,0,0), C0,4); \
    VRD(1,6); KRD(GL,0); CSUB(P0,1,ca_); CLD(ca_,2); GAPB(o[0]=__builtin_amdgcn_mfma_f32_32x32x16_bf16(PAF(1),VFR(2),o[0],0,0,0), C0,8); \
    VRD(2,3); KRD(GL,1); CSUB(P0,2,ca_); CLD(ca_,3); GAPB(o[1]=__builtin_amdgcn_mfma_f32_32x32x16_bf16(PAF(1),VFR(3),o[1],0,0,0), C0,12); \
    VRD(3,7); KRD(GL,2); CSUB(P0,3,ca_); CLD(ca_,4); GAPB(o[0]=__builtin_amdgcn_mfma_f32_32x32x16_bf16(PAF(2),VFR(0),o[0],0,0,0), C1,0); \
    KRD(GL,3); CSUB(P1,0,ca_); CLD(ca_,5); GAPB(o[1]=__builtin_amdgcn_mfma_f32_32x32x16_bf16(PAF(2),VFR(1),o[1],0,0,0), C1,4); \
    CSUB(P1,1,ca_); CLD(ca_,6); GAPB(o[0]=__builtin_amdgcn_mfma_f32_32x32x16_bf16(PAF(3),VFR(2),o[0],0,0,0), C1,8); \
    CSUB(P1,2,ca_); CLD(ca_,7); GAPB(o[1]=__builtin_amdgcn_mfma_f32_32x32x16_bf16(PAF(3),VFR(3),o[1],0,0,0), C1,12); \
    CSUB(P1,3,ca_); SBAR(); \
    }while(0)
  int t=1;
  #undef CMASK
  #define CMASK(P0,P1,t) do{}while(0)
  for(;t+5<NT;t+=2){
    STEP(pB0,pB1,pA0,pA1,t,true,true,true);     WAIT_BAR(2); RESC(); ROT();
    STEP(pA0,pA1,pB0,pB1,t+1,true,true,true);   WAIT_BAR(2); RESC(); ROT();
  }
  #undef CMASK
  #define CMASK(P0,P1,t) do{int jb_=(t)-(NT-4); if(jb_>=0)cmask(P0,P1,jb_,qrel,hi);}while(0)
  #define ENDW(tt) do{ if((tt)+3<NT){WAIT_BAR(2);} else if((tt)+2<NT){WAIT_BAR(1);} else {WAIT_BAR(0);} }while(0)
  for(;t+1<NT;t+=2){
    STEP(pB0,pB1,pA0,pA1,t,(t+3<NT),(t+1<NT),(t+1<NT));       ENDW(t);   RESC(); ROT();
    STEP(pA0,pA1,pB0,pB1,t+1,(t+4<NT),(t+2<NT),(t+2<NT));     ENDW(t+1); RESC(); ROT();
  }
  STEP(pB0,pB1,pA0,pA1,NT-1,false,false,false); RESC();
  { float sacc=pB0[0]+pB0[1]; _Pragma("unroll") for(int r=2;r<16;++r)sacc+=pB0[r]; _Pragma("unroll") for(int r=0;r<16;++r)sacc+=pB1[r]; l_reg+=sacc;
    pw0=(u32x4){PKW(pB0,0),PKW(pB0,2),PKW(pB0,4),PKW(pB0,6)};pw1=(u32x4){PKW(pB0,8),PKW(pB0,10),PKW(pB0,12),PKW(pB0,14)};pw2=(u32x4){PKW(pB1,0),PKW(pB1,2),PKW(pB1,4),PKW(pB1,6)};pw3=(u32x4){PKW(pB1,8),PKW(pB1,10),PKW(pB1,12),PKW(pB1,14)};
    SBAR(); pv(o,vb0+sl_cur,PAF(0),PAF(1),PAF(2),PAF(3)); }
  #undef PKW
  #undef PAF
  #undef VFR
  #undef PIN
  #undef MX3
  #undef GAPA
  #undef GAPB
  #undef EX
  #undef VRD
  #undef KRD
  #undef STEP
  #undef ENDW
  #undef CINIT
  #undef CQ
  #undef CLD
  #undef CSUB
  {auto rr=__builtin_amdgcn_permlane32_swap(__float_as_uint(l_reg),__float_as_uint(l_reg),false,false);l_reg=__uint_as_float(rr[0])+__uint_as_float(rr[1]);}
  if(hi==0)wsf[32+r32]=l_reg;asm volatile("s_waitcnt lgkmcnt(0)":::"memory");
  const float g0=gout[r32],g1=gout[32+r32];
  #pragma unroll
  for(int r=0;r<16;++r){ const float rl=__builtin_amdgcn_rcpf(wsf[32+crow(r,hi)]); const float y0=o[0][r]*rl,y1=o[1][r]*rl; float s=y0*y0+y1*y1;
    s+=xor_lane<1>(s); s+=xor_lane<2>(s); s+=xor_lane<4>(s); s+=xor_lane<8>(s); s+=xor_lane<16>(s);
    const float rs=__builtin_amdgcn_rsqf(s*(1.0f/64.0f)+1e-6f); o[0][r]=y0*rs*g0; o[1][r]=y1*rs*g1; }
  bf16*Ow=O+(rowbase+q0+wid*QBLK)*DMO+h*D;
  { bf16*stg=(bf16*)(shm+LDS_OST)+wid*2048;
    #pragma unroll
    for(int r=0;r<16;++r){const int orow=crow(r,hi);
      #pragma unroll
      for(int d0=0;d0<2;++d0)stg[orow*64+d0*32+r32]=__float2bfloat16(o[d0][r]);}
    asm volatile("s_waitcnt lgkmcnt(0)":::"memory");
    #pragma unroll
    for(int i=0;i<4;++i){const int row=i*8+(lane>>3),ch=lane&7; const u32x4 v=*(const u32x4*)(stg+row*64+ch*8); ATTN_STORE16(Ow+(long)row*DMO+ch*8,v);} }
  asm volatile("s_waitcnt lgkmcnt(0)\n\ts_barrier":::"memory");
  #undef DMA_K
  #undef DMA_V
  #undef CMASK
  #undef RESC
  #undef ROT
}
constexpr int ATTN_LDS_BYTES=LDS_BYTES;
struct AttnTensors { const bf16* Q; const bf16* K; const bf16* V; bf16* O; const float* CL; const float* gout; };
#undef SBAR
#undef WAIT_BAR
}

constexpr size_t MiB = 1u << 20;
constexpr size_t WS_CTL = 0, CTL_ZERO_BYTES = 1 * MiB;
constexpr size_t WS_WIN = 2 * MiB;
constexpr size_t WS_WO  = 8 * MiB;
constexpr size_t WS_WGU = 10 * MiB;
constexpr size_t WS_WD  = 21 * MiB;
constexpr size_t WS_WPG = 27 * MiB;
constexpr size_t WS_WPP = 29 * MiB;
constexpr size_t WS_LF  = 30 * MiB;
constexpr size_t WS_CL  = 32 * MiB;
constexpr size_t WS_SSQ1 = 34 * MiB;
constexpr size_t WS_SSQ2 = 38 * MiB;
constexpr size_t WS_IRX = 42 * MiB;
constexpr size_t WS_PB  = 48 * MiB;
constexpr size_t WS_XN  = 96 * MiB;
constexpr size_t WS_Z   = 224 * MiB;
constexpr size_t WS_Y   = 608 * MiB;
constexpr size_t WS_PROJ = 736 * MiB;
constexpr size_t WS_CUB = 864 * MiB;
constexpr size_t WS_END = 928 * MiB;
constexpr int CW_BAR = 4096;
constexpr size_t CTL_KN = 65536, CTL_QN = 131072, CTL_CONVQ = 196608;

constexpr int RING_OFF = 0, RING_BYTES = 131072;
constexpr int LDSCTL_OFF = RING_BYTES, MISC_OFF = LDSCTL_OFF + 320;
constexpr int SPARE_OFF = RING_BYTES + 1024;
constexpr int LDS_BYTES = 147456;
static_assert(MISC_OFF + 128 <= LDS_BYTES, "LDS map");
constexpr int NWAVES = 8;

#define GAS __attribute__((address_space(1)))
#define LAS __attribute__((address_space(3)))
typedef unsigned short bf16;
typedef unsigned v4u __attribute__((ext_vector_type(4)));
typedef float f32x4 __attribute__((ext_vector_type(4)));
typedef short bf16x8 __attribute__((ext_vector_type(8)));
typedef GAS unsigned gu32;
typedef GAS unsigned long long gu64;
#define RLX_AGENT __ATOMIC_RELAXED, __HIP_MEMORY_SCOPE_AGENT
#define LDS_WAIT() asm volatile("s_waitcnt lgkmcnt(0)" ::: "memory")
#define VM_WAIT() asm volatile("s_waitcnt vmcnt(0)" ::: "memory")
__device__ __forceinline__ unsigned long long rt() { return __builtin_amdgcn_s_memrealtime(); }
__device__ __forceinline__ unsigned f2bf(float f) { unsigned u = __builtin_bit_cast(unsigned, f); return (u + 0x7fffu + ((u >> 16) & 1u)) >> 16; }
__device__ __forceinline__ unsigned pk2(float lo, float hi) { return f2bf(lo) | (f2bf(hi) << 16); }

#define XB_TMO      128
#define XB_XCNT(j)  (256  + 64 * (j))
#define XB_XSUB(j)  (1280 + 64 * (j))
#define XB_XGEN(j)  (2304 + 64 * (j))
#define XB_TOP      3328
#define XB_TOPGEN   3392
#define XCD_BAR_WORDS 3456
#define XB_SPIN_CAP (1u << 18)

__device__ __forceinline__ unsigned xb_ld(unsigned* p)              { return __hip_atomic_load(p, __ATOMIC_RELAXED, __HIP_MEMORY_SCOPE_AGENT); }
__device__ __forceinline__ unsigned xb_add(unsigned* p, unsigned v) { return __hip_atomic_fetch_add(p, v, __ATOMIC_RELAXED, __HIP_MEMORY_SCOPE_AGENT); }
__device__ __forceinline__ unsigned xb_xcc_id() { return (unsigned)__builtin_amdgcn_s_getreg((3 << 11) | 20) & 0xFu; }
#define XB_SPIN(cond, bar) do { unsigned _sp = 0; while (cond) { __builtin_amdgcn_s_sleep(1); \
    if ((++_sp & 255u) == 0u) { if (xb_ld(&(bar)[XB_TMO])) break; if (_sp > XB_SPIN_CAP) { atomicAdd(&(bar)[XB_TMO], 1u); break; } } } } while (0)

struct XcdBarrier {
    int wave;
    unsigned* bar; unsigned x;
    volatile LAS unsigned* st;
};

__device__ __forceinline__ XcdBarrier xcd_barrier_post(unsigned* bar, volatile LAS unsigned* st, int wave) {
    XcdBarrier b; b.wave = wave; b.bar = bar; b.x = xb_xcc_id(); b.st = st;
    if (wave == 0 && pg8::fresh_lane() == 0) (void)xb_add(&bar[XB_XCNT(b.x)], 1u);
    return b;
}
__device__ __forceinline__ void xcd_barrier_complete(unsigned* bar, unsigned x, unsigned& nloc, unsigned& nx) {
    const unsigned G = gridDim.x * gridDim.y * gridDim.z;
    unsigned sum, cnt, mine, sp = 0u;
    for (;;) {
        sum = 0u; cnt = 0u; mine = 0u;
#pragma unroll
        for (unsigned j = 0; j < 16; ++j) { const unsigned c = xb_ld(&bar[XB_XCNT(j)]); sum += c; cnt += (c > 0u) ? 1u : 0u; mine = (j == x) ? c : mine; }
        if (sum == G) break;
        __builtin_amdgcn_s_sleep(1);
        if ((++sp & 255u) == 0u) { if (xb_ld(&bar[XB_TMO])) break; if (sp > XB_SPIN_CAP) { atomicAdd(&bar[XB_TMO], 1u); break; } }
    }
    nloc = mine > 0u ? mine : 1u; nx = cnt > 0u ? cnt : 1u;
}

__device__ __forceinline__ void xcd_barrier(const XcdBarrier& b) {
    asm volatile("s_waitcnt vmcnt(0)" ::: "memory");
    __syncthreads();
    if (b.wave == 0 && pg8::fresh_lane() == 0) {
        unsigned* bar = b.bar;
        __builtin_amdgcn_s_waitcnt(0);
        unsigned nloc = b.st[0], nx = b.st[1];
        if (nloc == 0u) { xcd_barrier_complete(bar, b.x, nloc, nx); b.st[0] = nloc; b.st[1] = nx; }
        const unsigned old = xb_add(&bar[XB_XSUB(b.x)], 1u);
        const unsigned gen = old / nloc;
        if (old + 1u == (gen + 1u) * nloc) {
            __builtin_amdgcn_fence(__ATOMIC_RELEASE, "agent");
            asm volatile("s_waitcnt vmcnt(0)" ::: "memory");
            const unsigned og = xb_add(&bar[XB_TOP], 1u);
            const unsigned tg = og / nx;
            if (og + 1u == (tg + 1u) * nx) xb_add(&bar[XB_TOPGEN], 1u);
            else XB_SPIN(xb_ld(&bar[XB_TOPGEN]) == tg, bar);
            __builtin_amdgcn_fence(__ATOMIC_ACQUIRE, "agent");
            xb_add(&bar[XB_XGEN(b.x)], 1u);
            asm volatile("s_waitcnt vmcnt(0)" ::: "memory");
        } else {
            XB_SPIN(xb_ld(&bar[XB_XGEN(b.x)]) == gen, bar);
            __builtin_amdgcn_fence(__ATOMIC_ACQUIRE, "agent");
            asm volatile("s_waitcnt vmcnt(0)" ::: "memory");
        }
    }
    __syncthreads();
}

struct Frame {
    LAS unsigned char* lds;
    volatile LAS unsigned* MISC;
    int tid, lane, wave;
    int vcu, G;
    const float *x, *p, *mix_norm, *w_in, *b_f, *conv_w, *mix_out_norm, *w_o, *ffn_norm, *w_gu, *w_d, *ple_norm, *w_pg, *b_pg, *w_pp, *final_norm;
    float* out;
    bf16 *Win_t, *Wo_t, *Wgu_t, *Wd_t, *Wpg_t, *Wpp_t;
    float *LF, *CL, *SSQ1, *SSQ2;
    bf16 *PB, *XN, *Z, *Y, *PROJ;
    unsigned char* ws;
};
__device__ __forceinline__ float wave_sum(float v) {
#define WS_DPP(x, ctrl) __int_as_float(__builtin_amdgcn_update_dpp(0, __float_as_int(x), (ctrl), 0xf, 0xf, true))
    v += WS_DPP(v, 0xB1); v += WS_DPP(v, 0x4E); v += WS_DPP(v, 0x141); v += WS_DPP(v, 0x140);
#undef WS_DPP
    v += __int_as_float(__builtin_amdgcn_ds_swizzle(__float_as_int(v), (16 << 10) | 0x1f));
    { auto rr = __builtin_amdgcn_permlane32_swap(__float_as_uint(v), __float_as_uint(v), false, false); v = __uint_as_float(rr[0]) + __uint_as_float(rr[1]); }
    return v;
}
__device__ __forceinline__ void p0_transpose_item(const float* W, int ldw, int K, bf16* WT, int k0, int n0src, int drow0, const float* gain, LAS float* scr, int lane) {
    const int kq = lane >> 3, nq = (lane & 7) * 4;
    f32x4 v[8];
#pragma unroll
    for (int i = 0; i < 8; ++i) v[i] = *(const GAS f32x4*)(W + (size_t)(k0 + 8 * i + kq) * ldw + n0src + nq);
#pragma unroll
    for (int i = 0; i < 8; ++i) { const int kk = 8 * i + kq; f32x4 x = v[i]; if (gain) x = x * gain[k0 + kk];
        scr[kk * 33 + nq] = x.x; scr[kk * 33 + nq + 1] = x.y; scr[kk * 33 + nq + 2] = x.z; scr[kk * 33 + nq + 3] = x.w; }
    LDS_WAIT(); asm volatile("" ::: "memory");
    const int c = lane & 7;
#pragma unroll
    for (int j = 0; j < 4; ++j) { const int n = (lane >> 3) + 8 * j; const LAS float* s = scr + (8 * c) * 33 + n;
        v4u o; o.x = pk2(s[0 * 33], s[1 * 33]); o.y = pk2(s[2 * 33], s[3 * 33]); o.z = pk2(s[4 * 33], s[5 * 33]); o.w = pk2(s[6 * 33], s[7 * 33]);
        *(GAS v4u*)(WT + (size_t)(drow0 + n) * K + k0 + 8 * c) = o; }
    LDS_WAIT(); asm volatile("" ::: "memory");
}
__device__ __forceinline__ float log_sigmoid_f(float v) { return v < 0.f ? v - log1pf(expf(v)) : -log1pf(expf(-v)); }
__device__ __forceinline__ void p0_row(Frame& F, int m, const f32x4 (&gw)[8][4], const f32x4 (&g)[4], const f32x4 (&v)[4]) {
    float s = 0.f, zf[8];
#pragma unroll
    for (int h = 0; h < 8; ++h) zf[h] = 0.f;
#pragma unroll
    for (int j = 0; j < 4; ++j) { s += (v[j].x * v[j].x + v[j].y * v[j].y) + (v[j].z * v[j].z + v[j].w * v[j].w);
#pragma unroll
        for (int h = 0; h < 8; ++h) zf[h] += (v[j].x * gw[h][j].x + v[j].y * gw[h][j].y) + (v[j].z * gw[h][j].z + v[j].w * gw[h][j].w); }
    const float irs = sqrtf(wave_sum(s) * (1.f / DM) + EPS), rstd = 1.f / irs;
    if (F.lane == 0) ((float*)(F.ws + WS_IRX))[m] = irs;
    GAS unsigned long long* o8 = (GAS unsigned long long*)(F.XN + (size_t)m * DM) + F.lane;
#pragma unroll
    for (int j = 0; j < 4; ++j) { const f32x4 xn = v[j] * rstd; o8[64 * j] = (unsigned long long)pk2(xn.x, xn.y) | ((unsigned long long)pk2(xn.z, xn.w) << 32); }
#pragma unroll
    for (int h = 0; h < 8; ++h) zf[h] = wave_sum(zf[h]);
    float mine = zf[0];
#pragma unroll
    for (int h = 1; h < 8; ++h) mine = (F.lane == h) ? zf[h] : mine;
    if (F.lane < 8) { const int b = m / SEQ, sp = m % SEQ; F.LF[((size_t)(b * NH + F.lane)) * SEQ + sp] = log_sigmoid_f(mine * rstd + F.b_f[F.lane]); }
}
__device__ __forceinline__ void p0_prologue(Frame& F) {
    LAS float* scr = (LAS float*)(F.lds + RING_OFF + F.wave * 16384);
    const int gw = F.vcu * NWAVES + F.wave, NGW = F.G * NWAVES;
    constexpr int I_IN = 16 * 96, I_O = 16 * 32, I_GU = 16 * 176, I_D = 44 * 32, I_PG = 16 * 32, I_PP = 4 * 32;
    constexpr int NITEMS = I_IN + I_O + I_GU + I_D + I_PG + I_PP;
    for (int it = gw; it < NITEMS; it += NGW) {
        int r = it;
        if (r < I_IN) { const int kb = r / 96, nb = r % 96, n0 = 32 * nb; int drow = n0;
                        if (n0 >= 512 && n0 < 1536) { const int bjj = n0 >= 1024 ? 1 : 0, ch0 = n0 - 512 - 512 * bjj; drow = 256 * (2 + ch0 / 128) + 64 * ((ch0 % 128) / 32) + 32 * bjj; }
                        p0_transpose_item(F.w_in, INC, DM, F.Win_t, 64 * kb, n0, drow, F.mix_norm, scr, F.lane); continue; } r -= I_IN;
        if (r < I_O)  { const int kb = r / 32, nb = r % 32; p0_transpose_item(F.w_o, DM, DM, F.Wo_t, 64 * kb, 32 * nb, 32 * nb, nullptr, scr, F.lane); continue; } r -= I_O;
        if (r < I_GU) { const int kb = r / 176, nb = r % 176, n0 = 32 * nb, up = n0 >= FF ? 1 : 0, j = n0 - up * FF; const int drow = 256 * (j / 128) + 128 * up + (j % 128);
                        p0_transpose_item(F.w_gu, 2 * FF, DM, F.Wgu_t, 64 * kb, n0, drow, F.ffn_norm, scr, F.lane); continue; } r -= I_GU;
        if (r < I_D)  { const int kb = r / 32, nb = r % 32; p0_transpose_item(F.w_d, DM, FF, F.Wd_t, 64 * kb, 32 * nb, 32 * nb, nullptr, scr, F.lane); continue; } r -= I_D;
        if (r < I_PG) { const int kb = r / 32, nb = r % 32; p0_transpose_item(F.w_pg, DM, DM, F.Wpg_t, 64 * kb, 32 * nb, 32 * nb, F.ple_norm, scr, F.lane); continue; } r -= I_PG;
        { const int kb = r / 32, nb = r % 32; p0_transpose_item(F.w_pp, DM, PLE, F.Wpp_t, 64 * kb, 32 * nb, 32 * nb, nullptr, scr, F.lane); }
    }
    __syncthreads();
    LAS float* wfT = (LAS float*)(F.lds + RING_OFF);
    for (int e = F.tid; e < 8 * DM; e += NWAVES * 64) { const int k = e >> 3, h = e & 7; wfT[h * DM + k] = F.w_in[(size_t)k * INC + 3072 + h]; }
    __syncthreads();
    {
        f32x4 g[4], gwv[8][4];
#pragma unroll
        for (int j = 0; j < 4; ++j) { g[j] = ((const GAS f32x4*)F.mix_norm)[F.lane + 64 * j];
#pragma unroll
            for (int h = 0; h < 8; ++h) gwv[h][j] = *(const LAS f32x4*)(wfT + h * 1024 + 256 * j + 4 * F.lane) * g[j]; }
        f32x4 va[2][4], vb[2][4];
#define P0_LD(dst, m0_) do { _Pragma("unroll") for (int r = 0; r < 2; ++r) { const GAS f32x4* xr = (const GAS f32x4*)(F.x + (size_t)((m0_) + r) * DM) + F.lane; \
            _Pragma("unroll") for (int j = 0; j < 4; ++j) dst[r][j] = __builtin_nontemporal_load(xr + 64 * j); } } while (0)
        int m0 = gw * 2; const int mstep = NGW * 2;
        if (m0 < MTOK) P0_LD(va, m0);
        for (; m0 < MTOK; m0 += 2 * mstep) {
            const int m1 = m0 + mstep, m2 = m0 + 2 * mstep;
            if (m1 < MTOK) P0_LD(vb, m1);
#pragma unroll
            for (int r = 0; r < 2; ++r) p0_row(F, m0 + r, gwv, g, va[r]);
            if (m1 < MTOK) { if (m2 < MTOK) P0_LD(va, m2);
#pragma unroll
                for (int r = 0; r < 2; ++r) p0_row(F, m1 + r, gwv, g, vb[r]); }
        }
#undef P0_LD
    }
    { const GAS f32x4* p4 = (const GAS f32x4*)F.p; GAS unsigned long long* o8 = (GAS unsigned long long*)F.PB; const size_t n4 = (size_t)MTOK * PLE / 4, nthr = (size_t)F.G * (NWAVES * 64);
      for (size_t i = (size_t)blockIdx.x * (NWAVES * 64) + F.tid; i < n4; i += nthr * 8) { f32x4 v[8];
#pragma unroll
          for (int k = 0; k < 8; ++k) v[k] = __builtin_nontemporal_load(p4 + i + k * nthr);
#pragma unroll
          for (int k = 0; k < 8; ++k) o8[i + k * nthr] = (unsigned long long)pk2(v[k].x, v[k].y) | ((unsigned long long)pk2(v[k].z, v[k].w) << 32); } }
    __syncthreads();
}
__device__ __forceinline__ void scan_phase(Frame& F) {
    for (int seq = blockIdx.x; seq < NB * NH; seq += F.G) {
        const float* src = F.LF + (size_t)seq * SEQ + F.tid * 8;
        const f32x4 a = *(const f32x4*)src, b = *(const f32x4*)(src + 4);
        float pr[8]; pr[0] = a.x; pr[1] = pr[0] + a.y; pr[2] = pr[1] + a.z; pr[3] = pr[2] + a.w; pr[4] = pr[3] + b.x; pr[5] = pr[4] + b.y; pr[6] = pr[5] + b.z; pr[7] = pr[6] + b.w;
        const float tot = pr[7]; float inc = tot;
#pragma unroll
        for (int o = 1; o < 64; o <<= 1) { const float t = __shfl_up(inc, o); if (F.lane >= o) inc += t; }
        LAS float* wt = (LAS float*)(F.lds + RING_OFF);
        if (F.lane == 63) wt[F.wave] = inc;
        __syncthreads();
        float woff = 0.f;
#pragma unroll
        for (int w = 0; w < NWAVES; ++w) { const float t = wt[w]; if (w < F.wave) woff += t; }
        const float excl = woff + (inc - tot);
        float* dst = F.CL + (size_t)seq * SEQ + F.tid * 8;
        *(f32x4*)dst = (f32x4){(excl + pr[0]) * LOG2E, (excl + pr[1]) * LOG2E, (excl + pr[2]) * LOG2E, (excl + pr[3]) * LOG2E};
        *(f32x4*)(dst + 4) = (f32x4){(excl + pr[4]) * LOG2E, (excl + pr[5]) * LOG2E, (excl + pr[6]) * LOG2E, (excl + pr[7]) * LOG2E};
        __syncthreads();
    }
}
__device__ __forceinline__ void conv_phase(Frame& F) {
    const int ch = 8 * F.lane;
    float w0[8], w1[8], w2[8], gn[8];
    { const f32x4 a0 = *(const f32x4*)(F.conv_w + ch), a1 = *(const f32x4*)(F.conv_w + ch + 4), b0 = *(const f32x4*)(F.conv_w + 512 + ch), b1 = *(const f32x4*)(F.conv_w + 512 + ch + 4),
                  c0 = *(const f32x4*)(F.conv_w + 1024 + ch), c1 = *(const f32x4*)(F.conv_w + 1024 + ch + 4), g0 = *(const f32x4*)(F.mix_out_norm + ch), g1 = *(const f32x4*)(F.mix_out_norm + ch + 4);
#pragma unroll
      for (int i = 0; i < 4; ++i) { w0[i] = a0[i]; w0[4 + i] = a1[i]; w1[i] = b0[i]; w1[4 + i] = b1[i]; w2[i] = c0[i]; w2[4 + i] = c1[i]; gn[i] = g0[i]; gn[4 + i] = g1[i]; } }
#define UNPK8(dst, PKV) do { dst[0] = pg8::bf_lo(PKV.x); dst[1] = pg8::bf_hi(PKV.x); dst[2] = pg8::bf_lo(PKV.y); dst[3] = pg8::bf_hi(PKV.y); dst[4] = pg8::bf_lo(PKV.z); dst[5] = pg8::bf_hi(PKV.z); dst[6] = pg8::bf_lo(PKV.w); dst[7] = pg8::bf_hi(PKV.w); } while (0)
    unsigned* qctr = (unsigned*)(F.ws + WS_CTL + CTL_CONVQ);
    for (;;) {
        int chunk = 0; if (F.lane == 0) chunk = (int)__hip_atomic_fetch_add(qctr, 1u, __ATOMIC_RELAXED, __HIP_MEMORY_SCOPE_AGENT);
        chunk = __builtin_amdgcn_readfirstlane(chunk);
        if (chunk >= MTOK / 32) break;
        const int r0 = chunk * 32, s0 = r0 % SEQ;
        float cu1[8], cu2[8];
#pragma unroll
        for (int i = 0; i < 8; ++i) { cu1[i] = 0.f; cu2[i] = 0.f; }
        const bf16* CUB = (const bf16*)(F.ws + WS_CUB);
        if (s0 > 0) {
            const v4u c2w = *(const v4u*)(CUB + (size_t)(r0 - 2) * 512 + ch), c1w = *(const v4u*)(CUB + (size_t)(r0 - 1) * 512 + ch);
            UNPK8(cu2, c2w); UNPK8(cu1, c1w);
        }
#pragma unroll 4
        for (int t = 0; t < 32; ++t) {
            const bf16* zr = F.Z + (size_t)(r0 + t) * NZ + ch;
            const v4u bw = __builtin_nontemporal_load((const v4u*)zr), cw = __builtin_nontemporal_load((const v4u*)(CUB + (size_t)(r0 + t) * 512 + ch));
            float gb[8], gcu[8], yv[8]; UNPK8(gb, bw); UNPK8(gcu, cw);
            float ss = 0.f;
#pragma unroll
            for (int i = 0; i < 8; ++i) { const float cu0 = gcu[i]; const float cv = w0[i] * cu2[i] + w1[i] * cu1[i] + w2[i] * cu0; yv[i] = gb[i] * cv; ss += yv[i] * yv[i]; cu2[i] = cu1[i]; cu1[i] = cu0; }
            ss = pg8::sum_row8(ss);
            const float rs = 1.f / sqrtf(ss * (1.0f / 64.0f) + EPS);
            v4u o; o.x = pk2(yv[0] * rs * gn[0], yv[1] * rs * gn[1]); o.y = pk2(yv[2] * rs * gn[2], yv[3] * rs * gn[3]); o.z = pk2(yv[4] * rs * gn[4], yv[5] * rs * gn[5]); o.w = pk2(yv[6] * rs * gn[6], yv[7] * rs * gn[7]);
            *(GAS v4u*)(F.Y + (size_t)(r0 + t) * DM + ch) = o;
        }
    }
#undef UNPK8
}
__device__ __forceinline__ void final_phase(Frame& F) {
    const int gw = F.vcu * NWAVES + F.wave, NGW = F.G * NWAVES;
    typedef unsigned u32x2_t __attribute__((ext_vector_type(2)));
    f32x4 g[4];
#pragma unroll
    for (int j = 0; j < 4; ++j) g[j] = ((const GAS f32x4*)F.final_norm)[F.lane + 64 * j];
    for (int m0 = gw * 16; m0 < MTOK; m0 += NGW * 16) {
        u32x2_t w[16][4];
#pragma unroll
        for (int r = 0; r < 16; ++r) { const GAS u32x2_t* hr = (const GAS u32x2_t*)(F.XN + (size_t)(m0 + r) * DM) + F.lane;
#pragma unroll
            for (int j = 0; j < 4; ++j) w[r][j] = hr[64 * j]; }
#pragma unroll
        for (int r = 0; r < 16; ++r) { f32x4 v[4]; float s = 0.f;
#pragma unroll
            for (int j = 0; j < 4; ++j) { v[j] = (f32x4){pg8::bf_lo(w[r][j].x), pg8::bf_hi(w[r][j].x), pg8::bf_lo(w[r][j].y), pg8::bf_hi(w[r][j].y)}; s += (v[j].x * v[j].x + v[j].y * v[j].y) + (v[j].z * v[j].z + v[j].w * v[j].w); }
            const float rstd = 1.f / sqrtf(wave_sum(s) * (1.f / DM) + EPS);
            GAS f32x4* orow = (GAS f32x4*)(F.out + (size_t)(m0 + r) * DM) + F.lane;
#pragma unroll
            for (int j = 0; j < 4; ++j) orow[64 * j] = v[j] * rstd * g[j]; }
    }
}
__device__ __forceinline__ void attn_phase(Frame& F, char* ldsbase, const float* KN, const float* QN) {
    const attn_body::bf16* Zb = (const attn_body::bf16*)F.Z;
    const int g = F.vcu >> 3, j = F.vcu & 7;
    if (F.G == 256) {
        const int h0 = g & 7, bs = g >> 3;
        volatile LAS unsigned* T0 = F.MISC + 16;
#define ATT_UNIT_OF(u_, b_, hh_, qb_) const int r_ = (u_) >> 1, hh_ = (r_ == 0) ? h0 : (r_ == 1) ? 7 - h0 : (r_ == 2) ? ((h0 + 4) & 7) : 7 - ((h0 + 4) & 7), \
            jj_ = (r_ == 0) ? j : (r_ == 1) ? 7 - j : (r_ == 2) ? ((j + 4) & 7) : 7 - ((j + 4) & 7), b_ = 4 * r_ + bs, qb_ = ((u_) & 1) ? 15 - jj_ : jj_
        {
            const int u = F.wave; ATT_UNIT_OF(u, b, hh, qb); const int bh = b * NH + hh;
            const int t0 = attn_body::attn_skip_t0(qb, F.CL + (size_t)bh * SEQ, KN + (size_t)bh * 128, QN + ((size_t)bh * 16 + qb) * 2, F.lane);
            if (F.lane == 0) T0[u] = (unsigned)t0;
        }
        __syncthreads();
        for (int u = 0; u < 8; ++u) { ATT_UNIT_OF(u, b, hh, qb); const int bh = b * NH + hh; const int t0 = __builtin_amdgcn_readfirstlane((int)T0[u]);
            if (t0 >> 16) attn_body::attn_unit<8, true>(b, hh, qb, Zb + 1536, Zb + 2048, Zb + 2560, (attn_body::bf16*)F.Y + 512, F.CL + (size_t)bh * SEQ, F.mix_out_norm + 512 + hh * HD, t0 & 0xffff, ldsbase, F.wave);
            else          attn_body::attn_unit<8, false>(b, hh, qb, Zb + 1536, Zb + 2048, Zb + 2560, (attn_body::bf16*)F.Y + 512, F.CL + (size_t)bh * SEQ, F.mix_out_norm + 512 + hh * HD, t0 & 0xffff, ldsbase, F.wave); }
#undef ATT_UNIT_OF
    } else {
        const int per = F.G >> 3;
        for (int bh = g; bh < NB * NH; bh += per) { const int b = bh / NH, h = bh % NH;
            for (int i = 0; i < 2; ++i) { const int qb = i ? 15 - j : j;
                const int t0 = attn_body::attn_skip_t0(qb, F.CL + (size_t)bh * SEQ, KN + (size_t)bh * 128, QN + ((size_t)bh * 16 + qb) * 2, F.lane);
                attn_body::attn_unit<8, false>(b, h, qb, Zb + 1536, Zb + 2048, Zb + 2560, (attn_body::bf16*)F.Y + 512, F.CL + (size_t)bh * SEQ, F.mix_out_norm + 512 + h * HD, t0 & 0xffff, ldsbase, F.wave); } }
    }
}

__device__ __forceinline__ bool fill_rstd_table(Frame& F, const float* SSQ, const pg8::StaticOrder& S, LAS float* tab) {
    if (F.G != 256 || S.nM != 256) return false;
    int pms[4] = {-1, -1, -1, -1};
    { pg8::Unit u; for (int i = 0; S.next(i, u); ++i) { const int sl = (u.pm >> 3) & 3;
#pragma unroll
          for (int q = 0; q < 4; ++q) if (q == sl) pms[q] = u.pm; } }
    if (F.tid < 256) {
#pragma unroll
        for (int q = 0; q < 4; ++q) { if (pms[q] < 0) continue; const f32x4* p = (const f32x4*)(SSQ + (size_t)(pms[q] * 256 + F.tid) * 16); const f32x4 a = (p[0] + p[1]) + (p[2] + p[3]);
            tab[q * 256 + F.tid] = __builtin_amdgcn_rsqf(((a[0] + a[1]) + (a[2] + a[3])) * (1.0f / 1024.0f) + 1e-6f); } }
    __syncthreads();
    return true;
}
struct Args { const float* in[16]; float* out; unsigned char* ws; int ph_lo, ph_hi, rep, pad; };
__device__ __forceinline__ void load_ptrs(Frame& F) {
    const __attribute__((address_space(4))) Args* ap = (const __attribute__((address_space(4))) Args*)__builtin_amdgcn_kernarg_segment_ptr();
    asm volatile("" : "+s"(ap));
    unsigned char* ws = ap->ws;
    F.x = ap->in[0]; F.p = ap->in[1]; F.mix_norm = ap->in[2]; F.w_in = ap->in[3]; F.b_f = ap->in[4]; F.conv_w = ap->in[5]; F.mix_out_norm = ap->in[6]; F.w_o = ap->in[7];
    F.ffn_norm = ap->in[8]; F.w_gu = ap->in[9]; F.w_d = ap->in[10]; F.ple_norm = ap->in[11]; F.w_pg = ap->in[12]; F.b_pg = ap->in[13]; F.w_pp = ap->in[14]; F.final_norm = ap->in[15];
    F.out = ap->out;
    F.Win_t = (bf16*)(ws + WS_WIN); F.Wo_t = (bf16*)(ws + WS_WO); F.Wgu_t = (bf16*)(ws + WS_WGU); F.Wd_t = (bf16*)(ws + WS_WD); F.Wpg_t = (bf16*)(ws + WS_WPG); F.Wpp_t = (bf16*)(ws + WS_WPP);
    F.LF = (float*)(ws + WS_LF); F.CL = (float*)(ws + WS_CL); F.SSQ1 = (float*)(ws + WS_SSQ1); F.SSQ2 = (float*)(ws + WS_SSQ2);
    F.PB = (bf16*)(ws + WS_PB); F.XN = (bf16*)(ws + WS_XN); F.Z = (bf16*)(ws + WS_Z); F.Y = (bf16*)(ws + WS_Y); F.PROJ = (bf16*)(ws + WS_PROJ);
    F.ws = ws;
}
constexpr int N_PHASES = 11;
__global__ void __launch_bounds__(NWAVES * 64, 2) mega_fwd(Args args) {
    extern __shared__ __attribute__((aligned(16))) unsigned char lds[];
    Frame F;
    F.lds = (LAS unsigned char*)lds;
    F.MISC = (volatile LAS unsigned*)(F.lds + MISC_OFF);
    F.tid = threadIdx.x; F.lane = F.tid & 63; F.wave = __builtin_amdgcn_readfirstlane(F.tid >> 6);
    F.G = gridDim.x; { const int bx = blockIdx.x; F.vcu = (F.G % 8 == 0) ? (bx % 8) * (F.G / 8) + bx / 8 : bx; }
    unsigned char* ws = args.ws;
    load_ptrs(F);
    for (int u = F.tid; u < (LDS_BYTES - LDSCTL_OFF) / 4; u += NWAVES * 64) ((LAS unsigned*)(F.lds + LDSCTL_OFF))[u] = 0u;
    __syncthreads();
    const int lo = args.ph_lo, hi = args.ph_hi;
    XcdBarrier bar; bar.wave = F.wave; bar.bar = (unsigned*)((gu32*)(ws + WS_CTL) + CW_BAR); bar.x = 0; bar.st = nullptr;
    const bool multi = (hi - lo) > 1;
    if (multi) bar = xcd_barrier_post((unsigned*)(ws + WS_CTL) + CW_BAR, F.MISC + 8, F.wave);
#ifndef PH_MASK
#define PH_MASK 0x7ff
#endif
#define IN(k) ((((PH_MASK) >> (k)) & 1) && lo <= (k) && (k) < hi)
#define SEAM(k) do { if (IN(k) && IN((k) + 1)) xcd_barrier(bar); } while (0)

#define PH(k, ...) do { const int np_ = 1 + ((args.rep == (k)) ? 1 : 0); for (int pass_ = 0; pass_ < np_; ++pass_) { if (IN(k)) { { int t_ = F.wave * 64 + pg8::fresh_lane(); asm volatile("" : "+v"(t_)); F.tid = t_; F.lane = t_ & 63; load_ptrs(F); }     \
        __VA_ARGS__ } if (pass_ + 1 < np_) xcd_barrier(bar); } } while (0)
    PH(0, p0_prologue(F);); SEAM(0);
    PH(1, scan_phase(F););
    PH(2,
        pg8::Gemm g{F.XN, F.Win_t, MTOK, NZ, DM}; pg8::StaticOrder S; S.init(MTOK, NZ, F.G, (int)blockIdx.x);
        pg8::EpiBf16Plain E{F.Z, NZ, 6, 8, QSCALE, (unsigned*)(F.ws + WS_CTL + CTL_KN), (unsigned*)(F.ws + WS_CTL + CTL_QN), (bf16*)(F.ws + WS_CUB)};
        pg8::gemm_phase<pg8::EpiBf16Plain, pg8::StaticOrder, PG8_ALIGN, PG8_SP2>(F.lds + RING_OFF, g, S, E, F.wave);
    ); SEAM(2);
    PH(3, attn_phase(F, (char*)lds + RING_OFF, (const float*)(F.ws + WS_CTL + CTL_KN), (const float*)(F.ws + WS_CTL + CTL_QN)););
    PH(4, conv_phase(F);); SEAM(4);
    PH(5,
        pg8::Gemm g{F.Y, F.Wo_t, MTOK, DM, DM}; pg8::StaticOrder S; S.init(MTOK, DM, F.G, (int)blockIdx.x);
        pg8::EpiRes<true> E{F.XN, F.XN, F.SSQ1, (const float*)(F.ws + WS_IRX)};
        pg8::gemm_phase<pg8::EpiRes<true>, pg8::StaticOrder, PG8_ALIGN, PG8_SP2>(F.lds + RING_OFF, g, S, E, F.wave);
    ); SEAM(5);
    PH(6,
        pg8::Gemm g{F.XN, F.Wgu_t, MTOK, 2 * FF, DM}; pg8::StaticOrder S; S.init(MTOK, 2 * FF, F.G, (int)blockIdx.x); S.rev = 1;
        LAS float* rt = (LAS float*)(F.lds + SPARE_OFF); const bool ok = fill_rstd_table(F, F.SSQ1, S, rt);
        pg8::EpiSwiglu E{F.Z, F.SSQ1, ok ? rt : nullptr};
        pg8::gemm_phase<pg8::EpiSwiglu, pg8::StaticOrder, PG8_ALIGN, PG8_SP2>(F.lds + RING_OFF, g, S, E, F.wave);
    ); SEAM(6);
    PH(7,
        pg8::Gemm g{F.Z, F.Wd_t, MTOK, DM, FF}; pg8::StaticOrder S; S.init(MTOK, DM, F.G, (int)blockIdx.x);
        pg8::EpiRes<false> E{F.XN, F.Y, F.SSQ2, nullptr};
        pg8::gemm_phase<pg8::EpiRes<false>, pg8::StaticOrder, PG8_ALIGN, PG8_SP2>(F.lds + RING_OFF, g, S, E, F.wave);
    );
    PH(8,
        pg8::Gemm g{F.PB, F.Wpp_t, MTOK, DM, PLE}; pg8::StaticOrder S; S.init(MTOK, DM, F.G, (int)blockIdx.x);
        pg8::EpiBf16Plain E{F.PROJ, DM, 0, 0, 1.f, nullptr, nullptr, nullptr};
        pg8::gemm_phase<pg8::EpiBf16Plain, pg8::StaticOrder, PG8_ALIGN, PG8_SP2>(F.lds + RING_OFF, g, S, E, F.wave);
    ); SEAM(8);
    PH(9,
        pg8::Gemm g{F.Y, F.Wpg_t, MTOK, DM, DM}; pg8::StaticOrder S; S.init(MTOK, DM, F.G, (int)blockIdx.x); S.rev = 1;
        LAS float* rt = (LAS float*)(F.lds + SPARE_OFF); const bool ok = fill_rstd_table(F, F.SSQ2, S, rt);
        pg8::EpiPle E{F.Y, F.PROJ, F.SSQ2, F.b_pg, F.XN, ok ? rt : nullptr};
        pg8::gemm_phase<pg8::EpiPle, pg8::StaticOrder, PG8_ALIGN, PG8_SP2>(F.lds + RING_OFF, g, S, E, F.wave);
    ); SEAM(9);
    PH(10, final_phase(F););
#undef PH
#undef IN
#undef SEAM
}

namespace naive {
typedef short bf16x8 __attribute__((ext_vector_type(8)));
typedef float f32x4 __attribute__((ext_vector_type(4)));
__device__ __forceinline__ float bf2f(unsigned short h) { return __uint_as_float((unsigned)h << 16); }
__device__ __forceinline__ unsigned short f2bf16(float f) { return (unsigned short)f2bf(f); }
struct NArgs { const unsigned short* A; const unsigned short* Bt; int M, N, K; int kind;
               const float* X; const unsigned short* Hin; unsigned short* Hout; const float* SSQ; const unsigned short* PROJ; const float* bg; float* OUT; };
__device__ __forceinline__ float nrstd(const float* ssq, int row) { float s = 0.f; for (int i = 0; i < 16; ++i) s += ssq[(size_t)row * 16 + i]; return 1.f / sqrtf(s * (1.f / 1024.f) + 1e-6f); }
__device__ __forceinline__ float nsig(float v) { return 1.f / (1.f + expf(-v)); }
__global__ void __launch_bounds__(256) naive_gemm(NArgs a) {
    const int lane = threadIdx.x & 63, w = threadIdx.x >> 6, fr = lane & 15, fq = lane >> 4;
    const int m0 = blockIdx.y * 64 + 16 * w, n0 = blockIdx.x * 64;
    f32x4 acc[4], acc2[4];
    for (int j = 0; j < 4; ++j) { acc[j] = (f32x4){0.f, 0.f, 0.f, 0.f}; acc2[j] = (f32x4){0.f, 0.f, 0.f, 0.f}; }
    const bool dual = a.kind == 6;
    for (int k0 = 0; k0 < a.K; k0 += 32) {
        const bf16x8 af = *(const bf16x8*)(a.A + (size_t)(m0 + fr) * a.K + k0 + 8 * fq);
        for (int j = 0; j < 4; ++j) {
            const int col = n0 + 16 * j + fr;
            int brow = col;
            if (dual) brow = 256 * (col / 128) + (col % 128);
            const bf16x8 bf = *(const bf16x8*)(a.Bt + (size_t)brow * a.K + k0 + 8 * fq);
            acc[j] = __builtin_amdgcn_mfma_f32_16x16x32_bf16(af, bf, acc[j], 0, 0, 0);
            if (dual) { const bf16x8 bf2 = *(const bf16x8*)(a.Bt + (size_t)(brow + 128) * a.K + k0 + 8 * fq); acc2[j] = __builtin_amdgcn_mfma_f32_16x16x32_bf16(af, bf2, acc2[j], 0, 0, 0); }
        }
    }
    for (int j = 0; j < 4; ++j)
        for (int r = 0; r < 4; ++r) {
            const int row = m0 + 4 * fq + r, col = n0 + 16 * j + fr; const float v = acc[j][r];
            switch (a.kind) {
                case 2: a.Hout[(size_t)row * 3072 + col] = f2bf16(v * ((col >= 1536 && col < 2048) ? QSCALE : 1.f)); break;
                case 5: a.Hout[(size_t)row * 1024 + col] = f2bf16(a.X[(size_t)row * 1024 + col] + v); break;
                case 6: { const float rs = nrstd(a.SSQ, row), g = v * rs, u = acc2[j][r] * rs; a.Hout[(size_t)row * 2816 + col] = f2bf16(g * nsig(g) * u); } break;
                case 7: a.Hout[(size_t)row * 1024 + col] = f2bf16(bf2f(a.Hin[(size_t)row * 1024 + col]) + v); break;
                case 8: a.Hout[(size_t)row * 1024 + col] = f2bf16(v); break;
                case 9: { const float rs = nrstd(a.SSQ, row); a.Hout[(size_t)row * 1024 + col] = f2bf16(bf2f(a.Hin[(size_t)row * 1024 + col]) + nsig(v * rs + a.bg[col]) * bf2f(a.PROJ[(size_t)row * 1024 + col])); } break;
            }
        }
}
__global__ void __launch_bounds__(256) naive_ssq(const unsigned short* H, float* SSQ) {
    const int row = blockIdx.x * 4 + (threadIdx.x >> 6), lane = threadIdx.x & 63; float s = 0.f;
    for (int c = lane; c < 1024; c += 64) { const float v = bf2f(H[(size_t)row * 1024 + c]); s += v * v; }
    for (int o = 1; o < 64; o <<= 1) s += __shfl_xor(s, o);
    if (lane < 16) SSQ[(size_t)row * 16 + lane] = lane == 0 ? s : 0.f;
}
__global__ void __launch_bounds__(64) naive_attn(const unsigned short* Z, const float* CL, const float* gout_all, unsigned short* Y) {
    __shared__ float Ks[64][64]; __shared__ float Vs[64][64]; __shared__ float Sc[64][64];
    const int tid = threadIdx.x, qblk = blockIdx.x % (SEQ / 64), bh = blockIdx.x / (SEQ / 64), b = bh / NH, h = bh % NH;
    const int t = qblk * 64 + tid; const size_t row = (size_t)b * SEQ + t;
    float q[64], o[64];
#pragma unroll
    for (int d = 0; d < 64; ++d) { q[d] = bf2f(Z[row * 3072 + 1536 + h * 64 + d]); o[d] = 0.f; }
    const float* cl = CL + (size_t)bh * SEQ; const float clq = cl[t];
    float m_run = -INFINITY, l = 0.f;
    for (int kt = 0; kt <= qblk; ++kt) {
        __syncthreads();
        { const size_t kr = (size_t)b * SEQ + kt * 64 + tid;
#pragma unroll
          for (int d = 0; d < 64; ++d) { Ks[tid][d] = bf2f(Z[kr * 3072 + 2048 + h * 64 + d]); Vs[tid][d] = bf2f(Z[kr * 3072 + 2560 + h * 64 + d]); } }
        __syncthreads();
        float tmax = -INFINITY;
        for (int j = 0; j < 64; ++j) { const int key = kt * 64 + j; float s = 0.f;
#pragma unroll
            for (int d = 0; d < 64; ++d) s += q[d] * Ks[j][d];
            s += clq - cl[key]; if (key > t) s = -INFINITY; Sc[j][tid] = s; tmax = fmaxf(tmax, s); }
        const float m_new = fmaxf(m_run, tmax), sc = exp2f(m_run - m_new); l *= sc;
#pragma unroll
        for (int d = 0; d < 64; ++d) o[d] *= sc;
        m_run = m_new;
        for (int j = 0; j < 64; ++j) { const float p = exp2f(Sc[j][tid] - m_new); l += p;
#pragma unroll
            for (int d = 0; d < 64; ++d) o[d] += p * Vs[j][d]; }
    }
    float ss = 0.f; const float rl = 1.f / l;
#pragma unroll
    for (int d = 0; d < 64; ++d) { o[d] *= rl; ss += o[d] * o[d]; }
    const float rs = 1.f / sqrtf(ss * (1.f / 64.f) + 1e-6f);
#pragma unroll
    for (int d = 0; d < 64; ++d) Y[row * 1024 + 512 + h * 64 + d] = f2bf16(o[d] * rs * gout_all[512 + h * 64 + d]);
}
}

extern "C" void kernel_launch(void* const* d_in, const int* in_sizes, int n_in, void* d_out, int out_size, void* d_ws, size_t ws_size, hipStream_t stream) {
    static int grid = 0;
    if (grid == 0) {
        if (n_in != 16 || in_sizes[0] != MTOK * DM || out_size != MTOK * DM || ws_size < WS_END) { fprintf(stderr, "kernel_launch: unexpected problem shape (n_in %d, in0 %d, out %d, ws %zu); nothing launched\n", n_in, n_in > 0 ? in_sizes[0] : -1, out_size, ws_size); grid = -1; return; }
        int dev = 0, cus = 0;
        if (hipGetDevice(&dev) != hipSuccess || hipDeviceGetAttribute(&cus, hipDeviceAttributeMultiprocessorCount, dev) != hipSuccess) { fprintf(stderr, "kernel_launch: device query failed\n"); grid = -1; return; }
        if (hipFuncSetAttribute((const void*)mega_fwd, hipFuncAttributeMaxDynamicSharedMemorySize, LDS_BYTES) != hipSuccess) { fprintf(stderr, "kernel_launch: hipFuncSetAttribute failed\n"); grid = -1; return; }
        (void)hipGetLastError();
        grid = cus;
        if (grid != 256) fprintf(stderr, "kernel_launch: note: %d CUs\n", grid);
    }
    if (grid < 0) return;
    if (hipMemsetAsync((char*)d_ws + WS_CTL, 0, CTL_ZERO_BYTES, stream) != hipSuccess) { fprintf(stderr, "kernel_launch: memset failed\n"); return; }
    Args a{};
    for (int i = 0; i < 16; ++i) a.in[i] = (const float*)d_in[i];
    a.out = (float*)d_out; a.ws = (unsigned char*)d_ws;
    unsigned char* ws = (unsigned char*)d_ws;
#ifndef PROBE_REP
#define PROBE_REP (-1)
#endif
    a.rep = PROBE_REP; a.pad = 0;
    auto mega = [&](int lo, int hi) { a.ph_lo = lo; a.ph_hi = hi; hipLaunchKernelGGL(mega_fwd, dim3(grid), dim3(NWAVES * 64), LDS_BYTES, stream, a); };
static_assert(((CFG_NAIVE_GEMM >> 2) & 1) == 0, "the reference in-proj kernel does not know the paired gate_c/u weight layout");
#if CFG_ONE_LAUNCH
    mega(0, N_PHASES);
#else
    auto ngemm = [&](int kind) {
        naive::NArgs n{}; n.kind = kind; n.M = MTOK;
        unsigned short* XN = (unsigned short*)(ws + WS_XN); unsigned short* Zp = (unsigned short*)(ws + WS_Z); unsigned short* Yp = (unsigned short*)(ws + WS_Y); unsigned short* PR = (unsigned short*)(ws + WS_PROJ);
        int ncols = 0;
        switch (kind) {
            case 2: n.A = XN; n.Bt = (unsigned short*)(ws + WS_WIN); n.K = DM; n.Hout = Zp; ncols = NZ; break;
            case 5: n.A = Yp; n.Bt = (unsigned short*)(ws + WS_WO); n.K = DM; n.X = (const float*)d_in[0]; n.Hout = XN; ncols = DM; break;
            case 6: n.A = XN; n.Bt = (unsigned short*)(ws + WS_WGU); n.K = DM; n.SSQ = (const float*)(ws + WS_SSQ1); n.Hout = Zp; ncols = FF; break;
            case 7: n.A = Zp; n.Bt = (unsigned short*)(ws + WS_WD); n.K = FF; n.Hin = XN; n.Hout = Yp; ncols = DM; break;
            case 8: n.A = (unsigned short*)(ws + WS_PB); n.Bt = (unsigned short*)(ws + WS_WPP); n.K = PLE; n.Hout = PR; ncols = DM; break;
            case 9: n.A = Yp; n.Bt = (unsigned short*)(ws + WS_WPG); n.K = DM; n.Hin = Yp; n.PROJ = PR; n.SSQ = (const float*)(ws + WS_SSQ2); n.bg = (const float*)d_in[13]; n.Hout = XN; ncols = DM; break;
        }
        n.N = ncols;
        hipLaunchKernelGGL(naive::naive_gemm, dim3(ncols / 64, MTOK / 64), dim3(256), 0, stream, n);
        if (kind == 5) hipLaunchKernelGGL(naive::naive_ssq, dim3(MTOK / 4), dim3(256), 0, stream, (const unsigned short*)XN, (float*)(ws + WS_SSQ1));
        if (kind == 7) hipLaunchKernelGGL(naive::naive_ssq, dim3(MTOK / 4), dim3(256), 0, stream, (const unsigned short*)Yp, (float*)(ws + WS_SSQ2));
    };
    for (int ph = 0; ph < N_PHASES; ++ph) {
        const bool is_gemm = (ph == 2 || ph == 5 || ph == 6 || ph == 7 || ph == 8 || ph == 9);
        if (is_gemm && ((CFG_NAIVE_GEMM >> ph) & 1)) { ngemm(ph); continue; }
        if (ph == 3 && CFG_NAIVE_ATTN) { hipLaunchKernelGGL(naive::naive_attn, dim3(NB * NH * (SEQ / 64)), dim3(64), 0, stream, (const unsigned short*)(ws + WS_Z), (const float*)(ws + WS_CL), (const float*)d_in[6], (unsigned short*)(ws + WS_Y)); continue; }
        mega(ph, ph + 1);
    }
#endif
    const hipError_t le = hipPeekAtLastError();
    if (le != hipSuccess) fprintf(stderr, "kernel_launch: launch failed: %s\n", hipGetErrorName(le));
}
```
